# Optimizing an MI355X kernel written in HIP

```python
import jax, jax.numpy as jnp
from jax import lax
import numpy as np

D_MODEL = 1024
BATCH = 4
SEQ = 8192
DEPTH = 2

CHUNK = 64
HEAD_DIM = 64
ATT_HEADS = 6
ATT_WIDTH = ATT_HEADS * HEAD_DIM
ATT_LEFT_CHUNKS = 8
ATT_BAND = (ATT_LEFT_CHUNKS + 1) * CHUNK
REL_CLIP = 128
CONV_WIDTH = D_MODEL // 4
CONV_KERNEL = 31
RET_HEADS = 6
RET_WIDTH = RET_HEADS * HEAD_DIM
D_MIX = ATT_WIDTH + CONV_WIDTH + RET_WIDTH
D_IN = 3 * ATT_WIDTH + 2 * CONV_WIDTH + 4 * RET_WIDTH
SPLITS = (ATT_WIDTH, 2 * ATT_WIDTH, 3 * ATT_WIDTH,
          3 * ATT_WIDTH + 2 * CONV_WIDTH,
          3 * ATT_WIDTH + 2 * CONV_WIDTH + RET_WIDTH,
          3 * ATT_WIDTH + 2 * CONV_WIDTH + 2 * RET_WIDTH,
          3 * ATT_WIDTH + 2 * CONV_WIDTH + 3 * RET_WIDTH)
D_FF = 4 * D_MODEL
ROPE_BASE = 10000.0
EPS = 1e-6
NEG_INF = -1e30

kernel_name = "hybrid_chunk_attn_conv_retention_encoder"


def rms_norm(x, g):
    xf = x.astype(jnp.float32)
    y = xf * lax.rsqrt(jnp.mean(xf * xf, axis=-1, keepdims=True) + EPS)
    return (y * g.astype(jnp.float32)).astype(x.dtype)


def layer_norm(x):
    xf = x.astype(jnp.float32)
    mu = jnp.mean(xf, axis=-1, keepdims=True)
    var = jnp.mean(jnp.square(xf - mu), axis=-1, keepdims=True)
    return (xf - mu) * lax.rsqrt(var + EPS)


def chunk_attention(q, k, v, rel_bias):
    b, s, _ = q.shape
    nc = s // CHUNK
    shp = (b, nc, CHUNK, ATT_HEADS, HEAD_DIM)
    q = q.reshape(shp) * (HEAD_DIM ** -0.5)
    k = k.reshape(shp)
    v = v.reshape(shp)
    pad = ((0, 0), (ATT_LEFT_CHUNKS, 0), (0, 0), (0, 0), (0, 0))
    kp, vp = jnp.pad(k, pad), jnp.pad(v, pad)
    band_idx = jnp.arange(nc)[:, None] + jnp.arange(ATT_LEFT_CHUNKS + 1)[None, :]
    kb = kp[:, band_idx].reshape(b, nc, ATT_BAND, ATT_HEADS, HEAD_DIM)
    vb = vp[:, band_idx].reshape(b, nc, ATT_BAND, ATT_HEADS, HEAD_DIM)
    scores = jnp.einsum('bnqhd,bnkhd->bnhqk', q, kb).astype(jnp.float32)
    qpos = jnp.arange(CHUNK)
    kpos = jnp.arange(ATT_BAND)
    rel = qpos[:, None] + ATT_LEFT_CHUNKS * CHUNK - kpos[None, :]
    rel_idx = jnp.clip(rel, -REL_CLIP, REL_CLIP) + REL_CLIP
    bias = rel_bias[:, rel_idx].astype(jnp.float32)
    key_chunk = jnp.arange(nc)[:, None] + (kpos // CHUNK)[None, :] - ATT_LEFT_CHUNKS
    valid = key_chunk >= 0
    scores = jnp.where(valid[None, :, None, None, :], scores + bias[None, None], NEG_INF)
    p = jax.nn.softmax(scores, axis=-1).astype(v.dtype)
    o = jnp.einsum('bnhqk,bnkhd->bnqhd', p, vb)
    return o.reshape(b, s, ATT_WIDTH)


def conv_module(u, conv_w, conv_b, ln_g, ln_b):
    a, gate = jnp.split(u, 2, axis=-1)
    y = a * jax.nn.sigmoid(gate)
    y = jnp.pad(y, ((0, 0), (CONV_KERNEL - 1, 0), (0, 0)))
    y = lax.conv_general_dilated(y, conv_w[:, None, :], (1,), 'VALID',
                                 dimension_numbers=('NWC', 'WIO', 'NWC'),
                                 feature_group_count=CONV_WIDTH) + conv_b
    y = layer_norm(y) * ln_g.astype(jnp.float32) + ln_b.astype(jnp.float32)
    return jax.nn.silu(y).astype(u.dtype)


def rotary(x, pos):
    half = HEAD_DIM // 2
    inv = 1.0 / (ROPE_BASE ** jnp.linspace(0.0, 1.0, half, dtype=jnp.float32))
    ang = pos[:, None] * inv[None, :]
    cos = jnp.cos(ang)[None, :, None, :]
    sin = jnp.sin(ang)[None, :, None, :]
    x1 = x[..., :half].astype(jnp.float32)
    x2 = x[..., half:].astype(jnp.float32)
    out = jnp.concatenate([x1 * cos - x2 * sin, x2 * cos + x1 * sin], axis=-1)
    return out.astype(x.dtype)


def retention(q, k, v, g):
    b, s, _ = q.shape
    nc = s // CHUNK
    dt = q.dtype
    pos = jnp.arange(s, dtype=jnp.float32)
    q = rotary(q.reshape(b, s, RET_HEADS, HEAD_DIM), pos)
    k = rotary(k.reshape(b, s, RET_HEADS, HEAD_DIM), pos) * (HEAD_DIM ** -0.5)
    shp = (b, nc, CHUNK, RET_HEADS, HEAD_DIM)
    qc, kc, vc = q.reshape(shp), k.reshape(shp), v.reshape(shp)
    log_g = jnp.log1p(-(2.0 ** (-5.0 - jnp.arange(RET_HEADS, dtype=jnp.float32))))
    idx = jnp.arange(CHUNK, dtype=jnp.float32)
    diff = idx[:, None] - idx[None, :]
    intra = jnp.where(diff >= 0, jnp.exp(jnp.maximum(diff, 0.0) * log_g[:, None, None]), 0.0)
    xi = jnp.exp((idx + 1.0)[None, :] * log_g[:, None]).astype(dt)
    zeta = jnp.exp((CHUNK - 1.0 - idx)[None, :] * log_g[:, None]).astype(dt)
    gamma_c = jnp.exp(CHUNK * log_g).astype(dt)
    sc = jnp.einsum('bnihd,bnjhd->bnhij', qc, kc) * intra.astype(dt)
    y_intra = jnp.einsum('bnhij,bnjhe->bnihe', sc, vc)
    kv = jnp.einsum('bnjhd,hj,bnjhe->nbhde', kc, zeta, vc)

    def step(state, kv_n):
        return state * gamma_c[None, :, None, None] + kv_n, state

    _, state_prev = lax.scan(step, jnp.zeros_like(kv[0]), kv)
    y_cross = jnp.einsum('bnihd,hi,nbhde->bnihe', qc, xi, state_prev)
    y = (y_intra + y_cross).reshape(b, s, RET_HEADS, HEAD_DIM)
    y = layer_norm(y).reshape(b, s, RET_WIDTH)
    return (jax.nn.silu(g.astype(jnp.float32)) * y).astype(dt)


def hybrid_layer(x, g_mix_pre, g_mix_post, g_mlp_pre, g_mlp_post, w_in, rel_bias,
                 conv_w, conv_b, conv_ln_g, conv_ln_b, w_out, w_up, w_down):
    h = rms_norm(x, g_mix_pre)
    u = h @ w_in
    aq, ak, av, cu, rq, rk, rv, rg = jnp.split(u, SPLITS, axis=-1)
    y_att = chunk_attention(aq, ak, av, rel_bias)
    y_conv = conv_module(cu, conv_w, conv_b, conv_ln_g, conv_ln_b)
    y_ret = retention(rq, rk, rv, rg)
    mix = jnp.concatenate([y_att, y_conv, y_ret], axis=-1) @ w_out
    x = x + rms_norm(mix, g_mix_post)
    h = rms_norm(x, g_mlp_pre)
    f = jnp.square(jax.nn.relu(h @ w_up)) @ w_down
    return x + rms_norm(f, g_mlp_post)


def setup_inputs(seed: int = 0) -> dict:
    key = jax.random.key(seed)
    ks = jax.random.split(key, 16)
    f32 = jnp.float32

    def nrm(k, shape, scale):
        return jax.random.normal(k, shape, f32) * scale

    def gain(k, shape):
        return 1.0 + nrm(k, shape, 0.02)

    return {
        "x": nrm(ks[0], (BATCH, SEQ, D_MODEL), 1.0),
        "norm_mix_pre": gain(ks[1], (DEPTH, D_MODEL)),
        "norm_mix_post": gain(ks[2], (DEPTH, D_MODEL)),
        "norm_mlp_pre": gain(ks[3], (DEPTH, D_MODEL)),
        "norm_mlp_post": gain(ks[4], (DEPTH, D_MODEL)),
        "w_in": nrm(ks[5], (DEPTH, D_MODEL, D_IN), D_MODEL ** -0.5),
        "attn_rel_bias": nrm(ks[6], (DEPTH, ATT_HEADS, 2 * REL_CLIP + 1), 0.5),
        "conv_w": nrm(ks[7], (DEPTH, CONV_KERNEL, CONV_WIDTH), CONV_KERNEL ** -0.5),
        "conv_b": nrm(ks[8], (DEPTH, CONV_WIDTH), 0.02),
        "conv_ln_g": gain(ks[9], (DEPTH, CONV_WIDTH)),
        "conv_ln_b": nrm(ks[10], (DEPTH, CONV_WIDTH), 0.02),
        "w_out": nrm(ks[11], (DEPTH, D_MIX, D_MODEL), D_MIX ** -0.5),
        "w_up": nrm(ks[12], (DEPTH, D_MODEL, D_FF), D_MODEL ** -0.5),
        "w_down": nrm(ks[13], (DEPTH, D_FF, D_MODEL), D_FF ** -0.5),
    }


def reference(x, norm_mix_pre, norm_mix_post, norm_mlp_pre, norm_mlp_post, w_in,
              attn_rel_bias, conv_w, conv_b, conv_ln_g, conv_ln_b, w_out, w_up, w_down):
    for l in range(DEPTH):
        x = hybrid_layer(x, norm_mix_pre[l], norm_mix_post[l], norm_mlp_pre[l], norm_mlp_post[l],
                         w_in[l], attn_rel_bias[l], conv_w[l], conv_b[l], conv_ln_g[l],
                         conv_ln_b[l], w_out[l], w_up[l], w_down[l])
    return x
```

```cpp
#include <hip/hip_runtime.h>
#include <hip/hip_cooperative_groups.h>
#include <cstdio>
#include <cstdint>
#include <cmath>
namespace cg = cooperative_groups;
namespace pg8 {
#define PG8_LAS __attribute__((address_space(3)))
typedef unsigned short bf16_t;
typedef short bf16x8 __attribute__((ext_vector_type(8)));
typedef float f32x4 __attribute__((ext_vector_type(4)));
typedef unsigned u32x4 __attribute__((ext_vector_type(4)));
constexpr int BM = 256, BK = 64, HALF = 128, HTB = HALF * BK * 2  , STAGE_BYTES = 8 * HTB, NXCD = 8, WGM = 8;

__host__ __device__ __forceinline__ int lds_byte(int r, int c) { const int st = (r >> 4) * 2 + (c >> 5), rr = r & 15, cc = c & 31, ob = rr * 64 + cc * 2; return st * 1024 + (ob ^ (((ob >> 9) & 1) << 5)); }
__host__ __device__ __forceinline__ void stage_rc(int b, int& R, int& C) { const int st = b / 1024, sb = b % 1024, swz = sb ^ (((sb >> 9) & 1) << 5); R = (st >> 1) * 16 + swz / 64; C = (st & 1) * 32 + (swz % 64) / 2; }
__host__ __device__ __forceinline__ int perm32(int rho) { const int n = rho >> 4, i = rho & 15; return 8 * (i >> 2) + 4 * n + (i & 3); }

struct Unit { int pm, pn; };
struct Gemm { const bf16_t* A; const bf16_t* Bt; int M, N, K; };

struct StaticOrder {
    int nM, nN, nwg, G, c;
    __host__ __device__ void init(int M, int N, int G_, int c_) { nM = M / BM; nN = N / BM; nwg = nM * nN; G = G_; c = c_; }
    __host__ __device__ bool next(int i, Unit& u) const {
        const long L = (long)i * G + c; if (L >= nwg) return false;
        int wgid = (int)L; { const int q = nwg / NXCD, r = nwg % NXCD, xcd = wgid % NXCD, off = wgid / NXCD; wgid = (xcd < r ? xcd * (q + 1) : r * (q + 1) + (xcd - r) * q) + off; }
        const int nig = WGM * nN, gid = wgid / nig, fm = gid * WGM, gsz = (nM - fm) < WGM ? (nM - fm) : WGM;
        u.pm = fm + ((wgid % nig) % gsz); u.pn = (wgid % nig) / gsz; return true;
    }
    __device__ __forceinline__ void a_ready(const Unit&) const {}
    __device__ __forceinline__ void done(const Unit&) const {}
};


__device__ __forceinline__ unsigned cvt_pk_bf16(float lo, float hi) { unsigned r; asm volatile("v_cvt_pk_bf16_f32 %0, %1, %2" : "=v"(r) : "v"(lo), "v"(hi)); return r; }
struct EpiOut {
    static constexpr bool PERM = true, AFTER_DRAIN = false;
    bf16_t* O; int ldc; int act;
    __device__ __forceinline__ void operator()(const f32x4 (&acc)[2][2][4][2], const Unit& u, int wr, int wc, int fr, int fq) const {
        const int row0 = u.pm * BM + wr * 64 + fr; const int col0 = u.pn * BM + wc * 32 + 8 * fq;
#pragma unroll
        for (int ai = 0; ai < 2; ++ai)
#pragma unroll
            for (int m = 0; m < 4; ++m) { bf16_t* rowp = O + (size_t)(row0 + ai * HALF + m * 16) * ldc + col0;
#pragma unroll
                for (int bj = 0; bj < 2; ++bj) { f32x4 v0 = acc[ai][bj][m][0], v1 = acc[ai][bj][m][1];
                    if (act) {
#pragma unroll
                        for (int e = 0; e < 4; ++e) { float a = fmaxf(v0[e], 0.f), b = fmaxf(v1[e], 0.f); v0[e] = a * a; v1[e] = b * b; } }
                    u32x4 w; w.x = cvt_pk_bf16(v0[0], v0[1]); w.y = cvt_pk_bf16(v0[2], v0[3]); w.z = cvt_pk_bf16(v1[0], v1[1]); w.w = cvt_pk_bf16(v1[2], v1[3]);
                    *(u32x4*)(rowp + bj * HALF) = w; } }
    }
};

template <class Epi, class Sched, bool ALIGN_EPI = false, bool SP2 = false>
__device__ __forceinline__ void gemm_phase(PG8_LAS unsigned char* lds, const Gemm g, const Sched& S, const Epi& E) {
    const int tid = threadIdx.x, wid = __builtin_amdgcn_readfirstlane(tid >> 6), lane = tid & 63, wr = wid >> 2, wc = wid & 3, fr = lane & 15, fq = lane >> 4;
    const int K = g.K, nt = K / BK;
    unsigned voffA[2], voffB[2];
#pragma unroll
    for (int i = 0; i < 2; ++i) { int R, C; stage_rc(tid * 16 + i * 8192, R, C); const int Rb = Epi::PERM ? ((R & ~31) + perm32(R & 31)) : R;
        voffA[i] = (unsigned)(R * K + C) * 2u; voffB[i] = (unsigned)(Rb * K + C) * 2u; }
    const size_t kstep = (size_t)(BK * 2);
    const size_t hstep = (size_t)HALF * K * 2;
    const size_t tstep = 2 * hstep;
    const unsigned ldsw = (unsigned)wid * 1024u;
    const int aoff = lds_byte(wr * 64 + fr, fq * 8), boff = lds_byte(wc * 32 + fr, fq * 8);
#define PG8_SA(b, h) (((b) * 2 + (h)) * HTB)
#define PG8_SB(b, h) ((4 + (b) * 2 + (h)) * HTB)
#define PG8_STAGE(bufoff, gbase, voff) do { _Pragma("unroll") for (int _i = 0; _i < 2; ++_i) \
        __builtin_amdgcn_global_load_lds((const unsigned*)((const char*)(gbase) + (voff)[_i]), (PG8_LAS unsigned*)(lds + (bufoff) + ldsw + _i * 8192), 16, 0, 0); } while (0)
#define PG8_LDA(dst, b, h) do { _Pragma("unroll") for (int m = 0; m < 4; ++m) _Pragma("unroll") for (int k = 0; k < 2; ++k) dst[m][k] = *(const PG8_LAS bf16x8*)(lds + PG8_SA(b, h) + aoff + m * 2048 + k * 1024); } while (0)
#define PG8_LDB(dst, b, h) do { _Pragma("unroll") for (int n = 0; n < 2; ++n) _Pragma("unroll") for (int k = 0; k < 2; ++k) dst[n][k] = *(const PG8_LAS bf16x8*)(lds + PG8_SB(b, h) + boff + n * 2048 + k * 1024); } while (0)
#define PG8_MMA(ai, bj, At, Bt) do { __builtin_amdgcn_s_setprio(1); _Pragma("unroll") for (int m = 0; m < 4; ++m) _Pragma("unroll") for (int n = 0; n < 2; ++n) _Pragma("unroll") for (int k = 0; k < 2; ++k) \
        acc[ai][bj][m][n] = __builtin_amdgcn_mfma_f32_16x16x32_bf16(Bt[n][k], At[m][k], acc[ai][bj][m][n], 0, 0, 0); __builtin_amdgcn_s_setprio(0); } while (0)
#define PG8_WAIT_V(n) asm volatile("s_waitcnt vmcnt(" #n ")" ::: "memory")
#define PG8_WAIT_L(n) asm volatile("s_waitcnt lgkmcnt(" #n ")" ::: "memory")
#define PG8_BAR __builtin_amdgcn_s_barrier()
#define PG8_SCHED __builtin_amdgcn_sched_barrier(0)
    Unit cur, nxt; int ui = 0;
    if (!S.next(0, cur)) return;
    f32x4 acc[2][2][4][2];
#pragma unroll
    for (int a = 0; a < 2; ++a)
#pragma unroll
        for (int b = 0; b < 2; ++b)
#pragma unroll
            for (int m = 0; m < 4; ++m)
#pragma unroll
                for (int n = 0; n < 2; ++n) acc[a][b][m][n] = (f32x4){0.f, 0.f, 0.f, 0.f};
    bf16x8 At[4][2], B0[2][2], B1[2][2];
    const char* cA = (const char*)g.A + (size_t)cur.pm * tstep; const char* cB = (const char*)g.Bt + (size_t)cur.pn * tstep;
    S.a_ready(cur);
    if constexpr (SP2) {
        PG8_STAGE(PG8_SB(0, 0), cB, voffB); PG8_STAGE(PG8_SB(0, 1), cB + hstep, voffB); PG8_STAGE(PG8_SA(0, 0), cA, voffA); PG8_STAGE(PG8_SA(0, 1), cA + hstep, voffA);
        if (wr == 1) PG8_BAR;
        PG8_WAIT_V(2); PG8_BAR;
        PG8_STAGE(PG8_SB(1, 0), cB + kstep, voffB); PG8_STAGE(PG8_SA(1, 0), cA + kstep, voffA); PG8_STAGE(PG8_SB(1, 1), cB + hstep + kstep, voffB);
        PG8_WAIT_V(6); PG8_BAR;
    } else {
        PG8_STAGE(PG8_SB(0, 0), cB, voffB); PG8_STAGE(PG8_SA(0, 0), cA, voffA); PG8_STAGE(PG8_SB(0, 1), cB + hstep, voffB); PG8_STAGE(PG8_SA(0, 1), cA + hstep, voffA);
        if (wr == 1) PG8_BAR;
        PG8_WAIT_V(4); PG8_BAR;
        PG8_STAGE(PG8_SB(1, 0), cB + kstep, voffB); PG8_STAGE(PG8_SA(1, 0), cA + kstep, voffA); PG8_STAGE(PG8_SB(1, 1), cB + hstep + kstep, voffB);
        PG8_WAIT_V(6); PG8_BAR;
    }
    for (;;) {
        const bool has_next = S.next(ui + 1, nxt);
        const char* nA = has_next ? (const char*)g.A + (size_t)nxt.pm * tstep : cA; const char* nB = has_next ? (const char*)g.Bt + (size_t)nxt.pn * tstep : cB;
        for (int t = 0; t < nt; t += 2) {
            const bool last = (t == nt - 2);
            const char* a1 = cA + (size_t)(t + 1) * kstep;
            const char* a2 = last ? nA : cA + (size_t)(t + 2) * kstep; const char* b2 = last ? nB : cB + (size_t)(t + 2) * kstep;
            const char* a3 = a2 + kstep; const char* b3 = b2 + kstep;
            if (last && has_next) S.a_ready(nxt);
            if constexpr (SP2) {
            PG8_LDB(B0, 0, 0); PG8_LDB(B1, 0, 1); PG8_SCHED; PG8_LDA(At, 0, 0); PG8_STAGE(PG8_SA(1, 1), a1 + hstep, voffA);
            PG8_WAIT_V(8); PG8_WAIT_L(0); PG8_BAR; PG8_MMA(0, 0, At, B0); PG8_MMA(0, 1, At, B1); PG8_BAR; PG8_SCHED;
            PG8_LDA(At, 0, 1); PG8_STAGE(PG8_SB(0, 0), b2, voffB); PG8_STAGE(PG8_SB(0, 1), b2 + hstep, voffB); PG8_STAGE(PG8_SA(0, 0), a2, voffA);
            PG8_WAIT_V(8); PG8_WAIT_L(0); PG8_BAR; PG8_MMA(1, 0, At, B0); PG8_MMA(1, 1, At, B1); PG8_BAR; PG8_SCHED;
            PG8_LDB(B0, 1, 0); PG8_LDB(B1, 1, 1); PG8_SCHED; PG8_LDA(At, 1, 0); PG8_STAGE(PG8_SA(0, 1), a2 + hstep, voffA);
            PG8_WAIT_V(8); PG8_WAIT_L(0); PG8_BAR; PG8_MMA(0, 0, At, B0); PG8_MMA(0, 1, At, B1); PG8_BAR; PG8_SCHED;
            PG8_LDA(At, 1, 1); PG8_STAGE(PG8_SB(1, 0), b3, voffB); PG8_STAGE(PG8_SB(1, 1), b3 + hstep, voffB); PG8_STAGE(PG8_SA(1, 0), a3, voffA);
            PG8_WAIT_V(8); PG8_WAIT_L(0); PG8_BAR; PG8_MMA(1, 0, At, B0); PG8_MMA(1, 1, At, B1); PG8_BAR; PG8_SCHED;
            } else {
            PG8_LDB(B0, 0, 0); PG8_SCHED; PG8_LDA(At, 0, 0); PG8_STAGE(PG8_SA(1, 1), a1 + hstep, voffA);
            PG8_WAIT_L(8); PG8_BAR; PG8_WAIT_L(0); PG8_MMA(0, 0, At, B0); PG8_BAR; PG8_SCHED;
            PG8_LDB(B1, 0, 1); PG8_STAGE(PG8_SB(0, 0), b2, voffB);
            PG8_BAR; PG8_WAIT_L(0); PG8_MMA(0, 1, At, B1); PG8_BAR;
            PG8_LDA(At, 0, 1); PG8_STAGE(PG8_SA(0, 0), a2, voffA);
            PG8_BAR; PG8_WAIT_L(0); PG8_MMA(1, 0, At, B0); PG8_BAR; PG8_SCHED;
            PG8_STAGE(PG8_SB(0, 1), b2 + hstep, voffB);
            PG8_WAIT_V(6); PG8_BAR; PG8_MMA(1, 1, At, B1); PG8_BAR;
            PG8_LDB(B0, 1, 0); PG8_SCHED; PG8_LDA(At, 1, 0); PG8_STAGE(PG8_SA(0, 1), a2 + hstep, voffA);
            PG8_WAIT_L(8); PG8_BAR; PG8_WAIT_L(0); PG8_MMA(0, 0, At, B0); PG8_BAR; PG8_SCHED;
            PG8_LDB(B1, 1, 1); PG8_STAGE(PG8_SB(1, 0), b3, voffB);
            PG8_BAR; PG8_WAIT_L(0); PG8_MMA(0, 1, At, B1); PG8_BAR;
            PG8_LDA(At, 1, 1); PG8_STAGE(PG8_SA(1, 0), a3, voffA);
            PG8_BAR; PG8_WAIT_L(0); PG8_MMA(1, 0, At, B0); PG8_BAR; PG8_SCHED;
            PG8_STAGE(PG8_SB(1, 1), b3 + hstep, voffB);
            PG8_WAIT_V(6); PG8_BAR; PG8_MMA(1, 1, At, B1); PG8_BAR;
            }
        }
        if constexpr (ALIGN_EPI) { if (wr == 0) PG8_BAR; }
        if constexpr (!Epi::AFTER_DRAIN) { E(acc, cur, wr, wc, fr, fq); S.done(cur); }
        if (!has_next) break;
#pragma unroll
        for (int a = 0; a < 2; ++a)
#pragma unroll
            for (int b = 0; b < 2; ++b)
#pragma unroll
                for (int m = 0; m < 4; ++m)
#pragma unroll
                    for (int n = 0; n < 2; ++n) acc[a][b][m][n] = (f32x4){0.f, 0.f, 0.f, 0.f};
        cur = nxt; cA = nA; cB = nB; ++ui;
        if constexpr (ALIGN_EPI) { if (wr == 1) PG8_BAR; }
    }
    PG8_WAIT_V(0);
    if constexpr (!ALIGN_EPI) { if (wr == 0) PG8_BAR; }
    PG8_BAR;
    if constexpr (Epi::AFTER_DRAIN) { E.fused(acc, cur, wr, wc, fr, fq, lds, wid, lane); S.done(cur); }
#undef PG8_SA
#undef PG8_SB
#undef PG8_STAGE
#undef PG8_LDA
#undef PG8_LDB
#undef PG8_MMA
#undef PG8_WAIT_V
#undef PG8_WAIT_L
#undef PG8_BAR
#undef PG8_SCHED
}
}

#define LAS __attribute__((address_space(3)))
typedef unsigned short bf16;
typedef short bf16x8 __attribute__((ext_vector_type(8)));
typedef float f32x4 __attribute__((ext_vector_type(4)));
typedef unsigned u32x4 __attribute__((ext_vector_type(4)));
typedef unsigned u32x2 __attribute__((ext_vector_type(2)));
constexpr int NWAVES = 8, NT = 512;
constexpr int BATCH = 4, SEQ = 8192, DM = 1024, M = BATCH * SEQ, DEPTH = 2;
constexpr int NC = SEQ / 64, AH = 6, RH = 6, CW = 256, CK = 31;
constexpr int DIN = 3200, DINP = 3328, DFF = 4096;
constexpr int U_AQ = 0, U_AK = 384, U_AV = 768, U_CA = 1152, U_CG = 1408, U_RQ = 1664, U_RK = 2048, U_RV = 2432, U_RG = 2816;
constexpr int Y_ATT = 0, Y_CONV = 384, Y_RET = 640;
constexpr float EPS = 1e-6f, LOG2E = 1.4426950408889634f;
constexpr size_t MiB = 1u << 20;
constexpr size_t WS_ROPE = 1 * MiB;
constexpr size_t WS_WIN = 4 * MiB;
constexpr size_t WS_WOUT = 17 * MiB;
constexpr size_t WS_WUP = 21 * MiB;
constexpr size_t WS_WDN = 37 * MiB;
constexpr size_t WS_H = 54 * MiB;
constexpr size_t WS_MIX = 118 * MiB;
constexpr size_t WS_KV = 118 * MiB;
constexpr size_t WS_ST = 182 * MiB;
constexpr size_t WS_U = 240 * MiB;
constexpr size_t WS_YMIX = 448 * MiB;
constexpr size_t WS_F1 = 240 * MiB;
constexpr size_t WS_END = 512 * MiB;
constexpr int LDS_BYTES = 147456;

__device__ __forceinline__ float bflo(unsigned w) { return __uint_as_float(w << 16); }
__device__ __forceinline__ float bfhi(unsigned w) { return __uint_as_float(w & 0xffff0000u); }
__device__ __forceinline__ unsigned pk2(float lo, float hi) { return pg8::cvt_pk_bf16(lo, hi); }
__device__ __forceinline__ float wave_sum(float v) {
#pragma unroll
    for (int o = 1; o < 64; o <<= 1) v += __shfl_xor(v, o);
    return v;
}
__device__ __forceinline__ float fexp2(float x) { return __builtin_amdgcn_exp2f(x); }
__device__ __forceinline__ float sigmoidf_(float x) { return 1.f / (1.f + fexp2(-x * LOG2E)); }
#define MFMA16(a, b, c) __builtin_amdgcn_mfma_f32_16x16x32_bf16((a), (b), (c), 0, 0, 0)

struct Args {
    const float* x; const float* g_mix_pre; const float* g_mix_post; const float* g_mlp_pre; const float* g_mlp_post;
    const float* w_in; const float* rel_bias; const float* conv_w; const float* conv_b; const float* conv_ln_g; const float* conv_ln_b;
    const float* w_out; const float* w_up; const float* w_down;
    float* out; unsigned char* ws;
    int ph_lo, ph_hi;
};

__device__ __forceinline__ void transpose_item(const float* W, int K, int N, bf16* WT, LAS float* scr, int item, int lane) {
    const int nblk = N / 32, kb = item / nblk, nb = item % nblk, k0 = 64 * kb, n0 = 32 * nb;
#pragma unroll 8
    for (int i = 0; i < 32; ++i) { const int kk = 2 * i + (lane >> 5); scr[kk * 33 + (lane & 31)] = W[(size_t)(k0 + kk) * N + n0 + (lane & 31)]; }
    asm volatile("s_waitcnt lgkmcnt(0)" ::: "memory");
    const int c = lane & 7;
#pragma unroll
    for (int j = 0; j < 4; ++j) { const int n = (lane >> 3) + 8 * j; const LAS float* s = scr + (8 * c) * 33 + n;
        u32x4 o; o.x = pk2(s[0 * 33], s[1 * 33]); o.y = pk2(s[2 * 33], s[3 * 33]); o.z = pk2(s[4 * 33], s[5 * 33]); o.w = pk2(s[6 * 33], s[7 * 33]);
        *(u32x4*)(WT + (size_t)(n0 + n) * K + k0 + 8 * c) = o; }
    asm volatile("s_waitcnt lgkmcnt(0)" ::: "memory");
}
__device__ __forceinline__ void rms_row_to_bf16(const float* xrow, const float* g, bf16* orow, int lane) {
    const f32x4* xr = (const f32x4*)xrow + lane; const f32x4* gr = (const f32x4*)g + lane;
    f32x4 v[4]; float s = 0.f;
#pragma unroll
    for (int j = 0; j < 4; ++j) { v[j] = xr[64 * j]; s += (v[j].x * v[j].x + v[j].y * v[j].y) + (v[j].z * v[j].z + v[j].w * v[j].w); }
    const float r = rsqrtf(wave_sum(s) * (1.f / DM) + EPS);
    u32x2* o8 = (u32x2*)orow + lane;
#pragma unroll
    for (int j = 0; j < 4; ++j) { const f32x4 gg = gr[64 * j]; u32x2 w; w.x = pk2(v[j].x * r * gg.x, v[j].y * r * gg.y); w.y = pk2(v[j].z * r * gg.z, v[j].w * r * gg.w); o8[64 * j] = w; }
}
__device__ __forceinline__ void prologue(const Args& a, LAS unsigned char* lds, int gw, int NGW, int wave, int lane) {
    unsigned char* ws = a.ws;
    LAS float* scr = (LAS float*)(lds + wave * 16384);
    constexpr int I_IN = (DM / 64) * (DIN / 32), I_OUT = (DM / 64) * (DM / 32), I_UP = (DM / 64) * (DFF / 32), I_DN = (DFF / 64) * (DM / 32);
    constexpr int PER_L = I_IN + I_OUT + I_UP + I_DN;
    for (int it = gw; it < DEPTH * PER_L; it += NGW) {
        const int l = it / PER_L; int r = it % PER_L;
        if (r < I_IN) { transpose_item(a.w_in + (size_t)l * DM * DIN, DM, DIN, (bf16*)(ws + WS_WIN) + (size_t)l * DINP * DM, scr, r, lane); continue; } r -= I_IN;
        if (r < I_OUT) { transpose_item(a.w_out + (size_t)l * DM * DM, DM, DM, (bf16*)(ws + WS_WOUT) + (size_t)l * DM * DM, scr, r, lane); continue; } r -= I_OUT;
        if (r < I_UP) { transpose_item(a.w_up + (size_t)l * DM * DFF, DM, DFF, (bf16*)(ws + WS_WUP) + (size_t)l * DFF * DM, scr, r, lane); continue; } r -= I_UP;
        transpose_item(a.w_down + (size_t)l * DFF * DM, DFF, DM, (bf16*)(ws + WS_WDN) + (size_t)l * DM * DFF, scr, r, lane);
    }
    for (int i = gw * 64 + lane; i < DEPTH * 16384; i += NGW * 64) { const int l = i / 16384, r = i % 16384;
        ((u32x4*)((bf16*)(ws + WS_WIN) + ((size_t)l * DINP + DIN) * DM))[r] = (u32x4){0u, 0u, 0u, 0u}; }
    float* ct = (float*)(ws + WS_ROPE); float* st = ct + SEQ * 32;
    for (int i = gw * 64 + lane; i < SEQ * 32; i += NGW * 64) { const int s = i >> 5, k = i & 31;
        const float lin = (k == 31) ? 1.0f : (float)k * (1.0f / 31.0f); const float invf = 1.0f / exp2f(lin * 13.287712379549449f); const float ang = (float)s * invf; double t = (double)ang * 0.15915494309189535; t -= rint(t); const float tf = (float)t;
        ct[i] = __builtin_amdgcn_cosf(tf); st[i] = __builtin_amdgcn_sinf(tf); }
    for (int m = gw; m < M; m += NGW) rms_row_to_bf16(a.x + (size_t)m * DM, a.g_mix_pre, (bf16*)(ws + WS_H) + (size_t)m * DM, lane);
}

__device__ __forceinline__ void ephase(const float* xold, const bf16* y, const float* ga, const float* gb, float* xout, bf16* hout, int gw, int NGW, int lane) {
    for (int m = gw; m < M; m += NGW) {
        const f32x4* xr = (const f32x4*)(xold + (size_t)m * DM) + lane; const u32x2* yr = (const u32x2*)(y + (size_t)m * DM) + lane;
        f32x4 xv[4], yv[4]; float s = 0.f;
#pragma unroll
        for (int j = 0; j < 4; ++j) { xv[j] = xr[64 * j]; const u32x2 w = yr[64 * j]; yv[j] = (f32x4){bflo(w.x), bfhi(w.x), bflo(w.y), bfhi(w.y)};
            s += (yv[j].x * yv[j].x + yv[j].y * yv[j].y) + (yv[j].z * yv[j].z + yv[j].w * yv[j].w); }
        const float r1 = rsqrtf(wave_sum(s) * (1.f / DM) + EPS); float s2 = 0.f;
        f32x4* xo = (f32x4*)(xout + (size_t)m * DM) + lane;
#pragma unroll
        for (int j = 0; j < 4; ++j) { const f32x4 gg = ((const f32x4*)ga)[lane + 64 * j]; xv[j] = xv[j] + yv[j] * r1 * gg; xo[64 * j] = xv[j];
            s2 += (xv[j].x * xv[j].x + xv[j].y * xv[j].y) + (xv[j].z * xv[j].z + xv[j].w * xv[j].w); }
        if (gb) { const float r2 = rsqrtf(wave_sum(s2) * (1.f / DM) + EPS); u32x2* ho = (u32x2*)(hout + (size_t)m * DM) + lane;
#pragma unroll
            for (int j = 0; j < 4; ++j) { const f32x4 gg = ((const f32x4*)gb)[lane + 64 * j]; u32x2 w; w.x = pk2(xv[j].x * r2 * gg.x, xv[j].y * r2 * gg.y); w.y = pk2(xv[j].z * r2 * gg.z, xv[j].w * r2 * gg.w); ho[64 * j] = w; } }
    }
}

constexpr int VTS = 72;
__device__ __forceinline__ void scatter8(LAS bf16* T, int row0, int col, u32x4 v) {
    T[(row0 + 0) * VTS + col] = (bf16)(v.x & 0xffffu); T[(row0 + 1) * VTS + col] = (bf16)(v.x >> 16);
    T[(row0 + 2) * VTS + col] = (bf16)(v.y & 0xffffu); T[(row0 + 3) * VTS + col] = (bf16)(v.y >> 16);
    T[(row0 + 4) * VTS + col] = (bf16)(v.z & 0xffffu); T[(row0 + 5) * VTS + col] = (bf16)(v.z >> 16);
    T[(row0 + 6) * VTS + col] = (bf16)(v.w & 0xffffu); T[(row0 + 7) * VTS + col] = (bf16)(v.w >> 16);
}
__device__ __forceinline__ bf16x8 ld_tr_pair(const LAS bf16* T, int row, int col_lo, int col_hi) {
    const u32x2 lo = *(const LAS u32x2*)(T + row * VTS + col_lo), hi = *(const LAS u32x2*)(T + row * VTS + col_hi);
    const u32x4 w = (u32x4){lo.x, lo.y, hi.x, hi.y}; return __builtin_bit_cast(bf16x8, w);
}
__device__ __forceinline__ bf16x8 pack_p(const f32x4 a, const f32x4 b) {
    const u32x4 w = (u32x4){pk2(a[0], a[1]), pk2(a[2], a[3]), pk2(b[0], b[1]), pk2(b[2], b[3])}; return __builtin_bit_cast(bf16x8, w);
}
__device__ __forceinline__ void attn_unit(LAS unsigned char* lds, const bf16* u, const float* relb, bf16* ymix, int b, int n, int hp, int tid, int wid, int lane) {
    const int fr = lane & 15, fq = lane >> 4;
    LAS bf16* Vt = (LAS bf16*)lds;
    LAS float* bl = (LAS float*)(lds + 128 * VTS * 2);
    __syncthreads();
    for (int i = tid; i < 2 * 257; i += NT) { const int hl = i / 257, k = i % 257; bl[hl * 260 + k] = relb[(2 * hp + hl) * 257 + k]; }
    const int hl = wid >> 2, qg = wid & 3, head = 2 * hp + hl;
    const size_t tok_q = (size_t)b * SEQ + n * 64 + qg * 16 + fr;
    bf16x8 Qb[2];
#pragma unroll
    for (int ks = 0; ks < 2; ++ks) Qb[ks] = *(const bf16x8*)(u + tok_q * DINP + U_AQ + head * 64 + ks * 32 + 8 * fq);
    float m_run = -1e30f, l_run = 0.f; f32x4 O[4];
#pragma unroll
    for (int dt = 0; dt < 4; ++dt) O[dt] = (f32x4){0.f, 0.f, 0.f, 0.f};
    const int c0 = n >= 8 ? 0 : 8 - n;
    for (int c = c0; c <= 8; ++c) {
        const size_t ktok0 = (size_t)b * SEQ + (size_t)(n + c - 8) * 64;
        __syncthreads();
        { const int key = tid >> 3, d0 = (tid & 7) * 16; const bf16* src = u + (ktok0 + key) * DINP + U_AV + (2 * hp) * 64 + d0;
          const u32x4 v0 = *(const u32x4*)src, v1 = *(const u32x4*)(src + 8); scatter8(Vt, d0, key, v0); scatter8(Vt, d0 + 8, key, v1); }
        __syncthreads();
        f32x4 st[4];
#pragma unroll
        for (int kt = 0; kt < 4; ++kt) { st[kt] = (f32x4){0.f, 0.f, 0.f, 0.f};
#pragma unroll
            for (int ks = 0; ks < 2; ++ks) { const bf16x8 Ka = *(const bf16x8*)(u + (ktok0 + kt * 16 + fr) * DINP + U_AK + head * 64 + ks * 32 + 8 * fq); st[kt] = MFMA16(Ka, Qb[ks], st[kt]); } }
        const int relbase = (qg * 16 + fr) + 64 * (8 - c); float mx = -1e30f;
#pragma unroll
        for (int kt = 0; kt < 4; ++kt)
#pragma unroll
            for (int r = 0; r < 4; ++r) { const int rel = relbase - (kt * 16 + 4 * fq + r); const int idx = (rel < 128 ? rel : 128) + 128;
                const float s = st[kt][r] * 0.125f + bl[hl * 260 + idx]; st[kt][r] = s; mx = fmaxf(mx, s); }
        mx = fmaxf(mx, __shfl_xor(mx, 16)); mx = fmaxf(mx, __shfl_xor(mx, 32));
        const float m_new = fmaxf(m_run, mx), alpha = fexp2((m_run - m_new) * LOG2E); float psum = 0.f;
#pragma unroll
        for (int kt = 0; kt < 4; ++kt)
#pragma unroll
            for (int r = 0; r < 4; ++r) { const float p = fexp2((st[kt][r] - m_new) * LOG2E); st[kt][r] = p; psum += p; }
        psum += __shfl_xor(psum, 16); psum += __shfl_xor(psum, 32);
        l_run = l_run * alpha + psum; m_run = m_new;
#pragma unroll
        for (int dt = 0; dt < 4; ++dt) O[dt] = O[dt] * alpha;
#pragma unroll
        for (int kk = 0; kk < 2; ++kk) { const bf16x8 pb = pack_p(st[2 * kk], st[2 * kk + 1]);
#pragma unroll
            for (int dt = 0; dt < 4; ++dt) { const bf16x8 Va = ld_tr_pair(Vt, hl * 64 + dt * 16 + fr, 32 * kk + 4 * fq, 32 * kk + 16 + 4 * fq); O[dt] = MFMA16(Va, pb, O[dt]); } }
    }
    const float inv = 1.f / l_run;
#pragma unroll
    for (int dt = 0; dt < 4; ++dt) { u32x2 w; w.x = pk2(O[dt][0] * inv, O[dt][1] * inv); w.y = pk2(O[dt][2] * inv, O[dt][3] * inv);
        *(u32x2*)(ymix + tok_q * DM + Y_ATT + head * 64 + dt * 16 + 4 * fq) = w; }
}

__device__ __forceinline__ void conv_unit(LAS unsigned char* lds, const bf16* u, const float* cw, const float* cb, const float* lng, const float* lnb, bf16* ymix, int b, int n, int tid, int wid, int lane) {
    LAS float* yb = (LAS float*)lds;
    __syncthreads();
    for (int i = tid; i < 94 * 32; i += NT) { const int tt = i >> 5, cgp = i & 31; const int t = n * 64 - 30 + tt;
        f32x4 o0 = (f32x4){0.f, 0.f, 0.f, 0.f}, o1 = o0;
        if (t >= 0) { const bf16* src = u + ((size_t)b * SEQ + t) * DINP + U_CA + cgp * 8; const u32x4 av = *(const u32x4*)src, gv = *(const u32x4*)(src + CW);
            o0 = (f32x4){bflo(av.x) * sigmoidf_(bflo(gv.x)), bfhi(av.x) * sigmoidf_(bfhi(gv.x)), bflo(av.y) * sigmoidf_(bflo(gv.y)), bfhi(av.y) * sigmoidf_(bfhi(gv.y))};
            o1 = (f32x4){bflo(av.z) * sigmoidf_(bflo(gv.z)), bfhi(av.z) * sigmoidf_(bfhi(gv.z)), bflo(av.w) * sigmoidf_(bflo(gv.w)), bfhi(av.w) * sigmoidf_(bfhi(gv.w))}; }
        *(LAS f32x4*)(yb + tt * 256 + cgp * 8) = o0; *(LAS f32x4*)(yb + tt * 256 + cgp * 8 + 4) = o1; }
    __syncthreads();
    const int ch = tid & 255, half = tid >> 8;
    float w[CK];
#pragma unroll
    for (int j = 0; j < CK; ++j) w[j] = cw[j * CW + ch];
    float acc[32]; const float bias = cb[ch];
#pragma unroll
    for (int i = 0; i < 32; ++i) acc[i] = bias;
#pragma unroll
    for (int r = 0; r < 62; ++r) { const float v = yb[(half * 32 + r) * 256 + ch];
#pragma unroll
        for (int i = 0; i < 32; ++i) if (r - i >= 0 && r - i < CK) acc[i] += w[r - i] * v; }
    __syncthreads();
#pragma unroll
    for (int i = 0; i < 32; ++i) yb[(half * 32 + i) * 256 + ch] = acc[i];
    __syncthreads();
    const f32x4 gg = ((const f32x4*)lng)[lane], bb = ((const f32x4*)lnb)[lane];
#pragma unroll
    for (int k = 0; k < 8; ++k) { const int t = wid * 8 + k; f32x4 v = *(const LAS f32x4*)(yb + t * 256 + 4 * lane);
        const float mean = wave_sum((v.x + v.y) + (v.z + v.w)) * (1.f / 256.f); v = v - mean;
        const float rstd = rsqrtf(wave_sum((v.x * v.x + v.y * v.y) + (v.z * v.z + v.w * v.w)) * (1.f / 256.f) + EPS);
        v = v * rstd * gg + bb; v = (f32x4){v.x * sigmoidf_(v.x), v.y * sigmoidf_(v.y), v.z * sigmoidf_(v.z), v.w * sigmoidf_(v.w)};
        u32x2 o; o.x = pk2(v.x, v.y); o.y = pk2(v.z, v.w);
        *(u32x2*)(ymix + ((size_t)b * SEQ + n * 64 + t) * DM + Y_CONV + 4 * lane) = o; }
}

__device__ __forceinline__ float ret_logg2(int h) { return log2f(1.f - exp2f(-5.f - (float)h)); }
__device__ __forceinline__ void rope8(const u32x4 a, const u32x4 c, const float* ct, const float* st, int pos, int dg, float scale, float (&o1)[8], float (&o2)[8]) {
    const f32x4 c0 = *(const f32x4*)(ct + pos * 32 + dg * 8), c1 = *(const f32x4*)(ct + pos * 32 + dg * 8 + 4);
    const f32x4 s0 = *(const f32x4*)(st + pos * 32 + dg * 8), s1 = *(const f32x4*)(st + pos * 32 + dg * 8 + 4);
    const float x1[8] = {bflo(a.x), bfhi(a.x), bflo(a.y), bfhi(a.y), bflo(a.z), bfhi(a.z), bflo(a.w), bfhi(a.w)};
    const float x2[8] = {bflo(c.x), bfhi(c.x), bflo(c.y), bfhi(c.y), bflo(c.z), bfhi(c.z), bflo(c.w), bfhi(c.w)};
    const float cs[8] = {c0.x, c0.y, c0.z, c0.w, c1.x, c1.y, c1.z, c1.w}, sn[8] = {s0.x, s0.y, s0.z, s0.w, s1.x, s1.y, s1.z, s1.w};
#pragma unroll
    for (int e = 0; e < 8; ++e) { o1[e] = (x1[e] * cs[e] - x2[e] * sn[e]) * scale; o2[e] = (x2[e] * cs[e] + x1[e] * sn[e]) * scale; }
}
__device__ __forceinline__ bf16x8 pack8(const float (&o)[8]) { const u32x4 w = (u32x4){pk2(o[0], o[1]), pk2(o[2], o[3]), pk2(o[4], o[5]), pk2(o[6], o[7])}; return __builtin_bit_cast(bf16x8, w); }
__device__ __forceinline__ void stage_vt(LAS bf16* Vt, const bf16* u, size_t tok0, int tid) {
    for (int i = tid; i < 64 * 48; i += NT) { const int j = i / 48, cg8 = i % 48; const u32x4 v = *(const u32x4*)(u + (tok0 + j) * DINP + U_RV + cg8 * 8); scatter8(Vt, cg8 * 8, j, v); }
}
__device__ __forceinline__ void retkv_unit(LAS unsigned char* lds, const bf16* u, const float* ct, const float* st, float* kv, int b, int n, int tid, int wid, int lane) {
    const int fr = lane & 15, fq = lane >> 4;
    LAS bf16* Vt = (LAS bf16*)lds; LAS bf16* Kt = Vt + 384 * VTS;
    const size_t tok0 = (size_t)b * SEQ + n * 64;
    __syncthreads();
    stage_vt(Vt, u, tok0, tid);
    for (int i = tid; i < 64 * 24; i += NT) { const int j = i / 24, r = i % 24, h = r >> 2, dg = r & 3;
        const bf16* src = u + (tok0 + j) * DINP + U_RK + h * 64 + dg * 8; const u32x4 a = *(const u32x4*)src, c = *(const u32x4*)(src + 32);
        float o1[8], o2[8]; rope8(a, c, ct, st, n * 64 + j, dg, 0.125f * fexp2((float)(63 - j) * ret_logg2(h)), o1, o2);
        const u32x4 w1 = (u32x4){pk2(o1[0], o1[1]), pk2(o1[2], o1[3]), pk2(o1[4], o1[5]), pk2(o1[6], o1[7])}, w2 = (u32x4){pk2(o2[0], o2[1]), pk2(o2[2], o2[3]), pk2(o2[4], o2[5]), pk2(o2[6], o2[7])};
        scatter8(Kt, h * 64 + dg * 8, j, w1); scatter8(Kt, h * 64 + 32 + dg * 8, j, w2); }
    __syncthreads();
    for (int t = wid; t < 24; t += NWAVES) { const int h = t >> 2, et = t & 3;
        bf16x8 Va[2];
#pragma unroll
        for (int ks = 0; ks < 2; ++ks) Va[ks] = *(const LAS bf16x8*)(Vt + (h * 64 + et * 16 + fr) * VTS + ks * 32 + 8 * fq);
        float* dst = kv + (((size_t)b * NC + n) * RH + h) * 4096;
#pragma unroll
        for (int dt = 0; dt < 4; ++dt) { f32x4 acc = (f32x4){0.f, 0.f, 0.f, 0.f};
#pragma unroll
            for (int ks = 0; ks < 2; ++ks) { const bf16x8 Kb = *(const LAS bf16x8*)(Kt + (h * 64 + dt * 16 + fr) * VTS + ks * 32 + 8 * fq); acc = MFMA16(Va[ks], Kb, acc); }
#pragma unroll
            for (int r = 0; r < 4; ++r) dst[(et * 16 + 4 * fq + r) * 64 + dt * 16 + fr] = acc[r]; }
    }
}
__device__ __forceinline__ void scan_phase(const float* kv, bf16* state, int gtid, int gthreads) {
    for (int g = gtid; g < BATCH * RH * 4096; g += gthreads) { const int ed = g & 4095, bh = g >> 12, h = bh % RH, b = bh / RH;
        const float gc = fexp2(64.f * ret_logg2(h)); float S = 0.f;
#pragma unroll 8
        for (int n = 0; n < NC; ++n) { const size_t idx = (((size_t)b * NC + n) * RH + h) * 4096 + ed; const float v = kv[idx]; state[idx] = (bf16)(pk2(S, 0.f) & 0xffffu); S = S * gc + v; }
    }
}
__device__ __forceinline__ void retout_unit(LAS unsigned char* lds, const bf16* u, const float* ct, const float* st, const bf16* state, bf16* ymix, int b, int n, int tid, int wid, int lane) {
    const int fr = lane & 15, fq = lane >> 4;
    LAS bf16* Vt = (LAS bf16*)lds;
    const size_t tok0 = (size_t)b * SEQ + n * 64;
    __syncthreads();
    stage_vt(Vt, u, tok0, tid);
    __syncthreads();
    for (int t = wid; t < 24; t += NWAVES) { const int h = t >> 2, ig = t & 3; const float lg2 = ret_logg2(h);
        const size_t tok_i = tok0 + ig * 16 + fr;
        bf16x8 Qb[2];
        { const bf16* src = u + tok_i * DINP + U_RQ + h * 64 + fq * 8; const u32x4 a = *(const u32x4*)src, c = *(const u32x4*)(src + 32);
          float o1[8], o2[8]; rope8(a, c, ct, st, n * 64 + ig * 16 + fr, fq, 1.f, o1, o2); Qb[0] = pack8(o1); Qb[1] = pack8(o2); }
        f32x4 y[4];
        const bf16* sp = state + (((size_t)b * NC + n) * RH + h) * 4096;
        const float xi = fexp2((float)(ig * 16 + fr + 1) * lg2);
#pragma unroll
        for (int et = 0; et < 4; ++et) { y[et] = (f32x4){0.f, 0.f, 0.f, 0.f};
#pragma unroll
            for (int ks = 0; ks < 2; ++ks) { const bf16x8 Sa = *(const bf16x8*)(sp + (et * 16 + fr) * 64 + ks * 32 + 8 * fq); y[et] = MFMA16(Sa, Qb[ks], y[et]); }
            y[et] = y[et] * xi; }
        f32x4 sc[4];
#pragma unroll
        for (int jt = 0; jt < 4; ++jt) { sc[jt] = (f32x4){0.f, 0.f, 0.f, 0.f};
            if (jt <= ig) {
                const bf16* src = u + (tok0 + jt * 16 + fr) * DINP + U_RK + h * 64 + fq * 8; const u32x4 a = *(const u32x4*)src, c = *(const u32x4*)(src + 32);
                float o1[8], o2[8]; rope8(a, c, ct, st, n * 64 + jt * 16 + fr, fq, 0.125f, o1, o2);
                sc[jt] = MFMA16(pack8(o1), Qb[0], sc[jt]); sc[jt] = MFMA16(pack8(o2), Qb[1], sc[jt]);
#pragma unroll
                for (int r = 0; r < 4; ++r) { const int dlt = (ig * 16 + fr) - (jt * 16 + 4 * fq + r); sc[jt][r] = dlt >= 0 ? sc[jt][r] * fexp2((float)dlt * lg2) : 0.f; }
            } }
#pragma unroll
        for (int kk = 0; kk < 2; ++kk) { const bf16x8 pb = pack_p(sc[2 * kk], sc[2 * kk + 1]);
#pragma unroll
            for (int et = 0; et < 4; ++et) { const bf16x8 Va = ld_tr_pair(Vt, h * 64 + et * 16 + fr, 32 * kk + 4 * fq, 32 * kk + 16 + 4 * fq); y[et] = MFMA16(Va, pb, y[et]); } }
        float s = 0.f;
#pragma unroll
        for (int et = 0; et < 4; ++et) s += (y[et][0] + y[et][1]) + (y[et][2] + y[et][3]);
        s += __shfl_xor(s, 16); s += __shfl_xor(s, 32);
        const float mean = s * (1.f / 64.f); float q = 0.f;
#pragma unroll
        for (int et = 0; et < 4; ++et) { y[et] = y[et] - mean; q += (y[et][0] * y[et][0] + y[et][1] * y[et][1]) + (y[et][2] * y[et][2] + y[et][3] * y[et][3]); }
        q += __shfl_xor(q, 16); q += __shfl_xor(q, 32);
        const float rstd = rsqrtf(q * (1.f / 64.f) + EPS);
#pragma unroll
        for (int et = 0; et < 4; ++et) { const u32x2 gw2 = *(const u32x2*)(u + tok_i * DINP + U_RG + h * 64 + et * 16 + 4 * fq);
            const float g0 = bflo(gw2.x), g1 = bfhi(gw2.x), g2 = bflo(gw2.y), g3 = bfhi(gw2.y);
            u32x2 o; o.x = pk2(g0 * sigmoidf_(g0) * y[et][0] * rstd, g1 * sigmoidf_(g1) * y[et][1] * rstd); o.y = pk2(g2 * sigmoidf_(g2) * y[et][2] * rstd, g3 * sigmoidf_(g3) * y[et][3] * rstd);
            *(u32x2*)(ymix + tok_i * DM + Y_RET + h * 64 + et * 16 + 4 * fq) = o; }
    }
}

constexpr int N_PHASES = 1 + 9 * DEPTH;
#define IN(k) (lo <= (k) && (k) < hi)
#ifdef NO_SYNC
#define SEAM(k) do { } while (0)
#else
#define SEAM(k) do { if (lo <= (k) && (k) + 1 < hi) { __syncthreads(); cg::this_grid().sync(); } } while (0)
#endif
template <int l> __device__ __forceinline__ void layer_phases(const Args& a, LAS unsigned char* lds, int lo, int hi, int tid, int lane, int wid, int G, int bx, int gw, int NGW) {
    unsigned char* ws = a.ws;
    bf16* Hb = (bf16*)(ws + WS_H); bf16* MIXb = (bf16*)(ws + WS_MIX); bf16* Ub = (bf16*)(ws + WS_U); bf16* YM = (bf16*)(ws + WS_YMIX); bf16* F1 = (bf16*)(ws + WS_F1);
    float* KV = (float*)(ws + WS_KV); bf16* STt = (bf16*)(ws + WS_ST);
    const float* ct = (const float*)(ws + WS_ROPE); const float* st = ct + SEQ * 32;
        const int pb = 1 + 9 * l;
        if (IN(pb + 0)) {
#ifndef NO_GEMM
            const pg8::Gemm g{Hb, (const bf16*)(ws + WS_WIN) + (size_t)l * DINP * DM, M, DINP, DM}; const pg8::EpiOut E{Ub, DINP, 0};
            pg8::StaticOrder S; S.init(M, DINP, G, bx);
            pg8::gemm_phase<pg8::EpiOut, pg8::StaticOrder, true, true>(lds, g, S, E);
#endif
        }
        SEAM(pb + 0);
        if (IN(pb + 1)) {
            const float* relb = a.rel_bias + (size_t)l * AH * 257;
            for (int it = bx; it < 1536 + 512 + 512; it += G) {
                if (it < 1536) {
#ifndef NO_ATTN
                    const int hp = it % 3, bn = it / 3; attn_unit(lds, Ub, relb, YM, bn / NC, bn % NC, hp, tid, wid, lane);
#endif
                } else if (it < 2048) {
#ifndef NO_CONV
                    const int bn = it - 1536; conv_unit(lds, Ub, a.conv_w + (size_t)l * CK * CW, a.conv_b + l * CW, a.conv_ln_g + l * CW, a.conv_ln_b + l * CW, YM, bn / NC, bn % NC, tid, wid, lane);
#endif
                } else {
#ifndef NO_RETKV
                    const int bn = it - 2048; retkv_unit(lds, Ub, ct, st, KV, bn / NC, bn % NC, tid, wid, lane);
#endif
                }
            }
        }
        SEAM(pb + 1);
        if (IN(pb + 2)) scan_phase(KV, STt, bx * NT + tid, G * NT);
        SEAM(pb + 2);
        if (IN(pb + 3)) {
#ifndef NO_RETOUT
            for (int it = bx; it < 512; it += G) retout_unit(lds, Ub, ct, st, STt, YM, it / NC, it % NC, tid, wid, lane);
#endif
        }
        SEAM(pb + 3);
        if (IN(pb + 4)) {
#ifndef NO_GEMM
            const pg8::Gemm g{YM, (const bf16*)(ws + WS_WOUT) + (size_t)l * DM * DM, M, DM, DM}; const pg8::EpiOut E{MIXb, DM, 0};
            pg8::StaticOrder S; S.init(M, DM, G, bx);
            pg8::gemm_phase<pg8::EpiOut, pg8::StaticOrder, true, true>(lds, g, S, E);
#endif
        }
        SEAM(pb + 4);
        if (IN(pb + 5)) ephase(l == 0 ? a.x : a.out, MIXb, a.g_mix_post + l * DM, a.g_mlp_pre + l * DM, a.out, Hb, gw, NGW, lane);
        SEAM(pb + 5);
        if (IN(pb + 6)) {
#ifndef NO_GEMM
            const pg8::Gemm g{Hb, (const bf16*)(ws + WS_WUP) + (size_t)l * DFF * DM, M, DFF, DM}; const pg8::EpiOut E{F1, DFF, 1};
            pg8::StaticOrder S; S.init(M, DFF, G, bx);
            pg8::gemm_phase<pg8::EpiOut, pg8::StaticOrder, true, true>(lds, g, S, E);
#endif
        }
        SEAM(pb + 6);
        if (IN(pb + 7)) {
#ifndef NO_GEMM
            const pg8::Gemm g{F1, (const bf16*)(ws + WS_WDN) + (size_t)l * DM * DFF, M, DM, DFF}; const pg8::EpiOut E{MIXb, DM, 0};
            pg8::StaticOrder S; S.init(M, DM, G, bx);
            pg8::gemm_phase<pg8::EpiOut, pg8::StaticOrder, true, true>(lds, g, S, E);
#endif
        }
        SEAM(pb + 7);
        if (IN(pb + 8)) ephase(a.out, MIXb, a.g_mlp_post + l * DM, (l + 1 < DEPTH) ? a.g_mix_pre + (l + 1) * DM : nullptr, a.out, Hb, gw, NGW, lane);
        SEAM(pb + 8);
    }
__global__ void __launch_bounds__(NT, 2) fwd_kernel(Args a) {
    extern __shared__ __attribute__((aligned(16))) unsigned char lds_raw[];
    LAS unsigned char* lds = (LAS unsigned char*)lds_raw;
    const int tid = threadIdx.x, lane = tid & 63, wid = __builtin_amdgcn_readfirstlane(tid >> 6);
    const int G = gridDim.x, bx = blockIdx.x;
    const int gw = bx * NWAVES + wid, NGW = G * NWAVES;
    unsigned char* ws = a.ws;
    bf16* Hb = (bf16*)(ws + WS_H); bf16* MIXb = (bf16*)(ws + WS_MIX); bf16* Ub = (bf16*)(ws + WS_U); bf16* YM = (bf16*)(ws + WS_YMIX); bf16* F1 = (bf16*)(ws + WS_F1);
    float* KV = (float*)(ws + WS_KV); bf16* STt = (bf16*)(ws + WS_ST);
    const float* ct = (const float*)(ws + WS_ROPE); const float* st = ct + SEQ * 32;
    const int lo = a.ph_lo, hi = a.ph_hi;
    if (IN(0)) prologue(a, lds, gw, NGW, wid, lane);
    SEAM(0);
    layer_phases<0>(a, lds, lo, hi, tid, lane, wid, G, bx, gw, NGW);
    layer_phases<1>(a, lds, lo, hi, tid, lane, wid, G, bx, gw, NGW);
}
#undef IN
#undef SEAM


#ifndef MULTI_LAUNCH
#define MULTI_LAUNCH 0
#endif
extern "C" void kernel_launch(void* const* d_in, const int* in_sizes, int n_in, void* d_out, int out_size, void* d_ws, size_t ws_size, hipStream_t stream) {
    static int grid = 0;
    if (grid == 0) {
        if (n_in != 14 || in_sizes[0] != M * DM || out_size != M * DM || ws_size < WS_END) { fprintf(stderr, "kernel_launch: unexpected shapes: n_in %d in0 %d out %d ws %zu\n", n_in, n_in > 0 ? in_sizes[0] : -1, out_size, ws_size); grid = -1; return; }
        int dev = 0, cus = 0, per_cu = 0;
        hipGetDevice(&dev); hipDeviceGetAttribute(&cus, hipDeviceAttributeMultiprocessorCount, dev);
        if (hipFuncSetAttribute((const void*)fwd_kernel, hipFuncAttributeMaxDynamicSharedMemorySize, LDS_BYTES) != hipSuccess) { fprintf(stderr, "kernel_launch: hipFuncSetAttribute failed\n"); grid = -1; return; }
        if (hipOccupancyMaxActiveBlocksPerMultiprocessor(&per_cu, (const void*)fwd_kernel, NT, LDS_BYTES) != hipSuccess || per_cu < 1) { fprintf(stderr, "kernel_launch: occupancy query says %d\n", per_cu); per_cu = 1; }
        (void)hipGetLastError();
        grid = cus * 1;
        fprintf(stderr, "kernel_launch: cus %d per_cu %d grid %d\n", cus, per_cu, grid);
    }
    if (grid < 0) return;
    Args a{};
    a.x = (const float*)d_in[0]; a.g_mix_pre = (const float*)d_in[1]; a.g_mix_post = (const float*)d_in[2]; a.g_mlp_pre = (const float*)d_in[3]; a.g_mlp_post = (const float*)d_in[4];
    a.w_in = (const float*)d_in[5]; a.rel_bias = (const float*)d_in[6]; a.conv_w = (const float*)d_in[7]; a.conv_b = (const float*)d_in[8]; a.conv_ln_g = (const float*)d_in[9]; a.conv_ln_b = (const float*)d_in[10];
    a.w_out = (const float*)d_in[11]; a.w_up = (const float*)d_in[12]; a.w_down = (const float*)d_in[13];
    a.out = (float*)d_out; a.ws = (unsigned char*)d_ws;
#if MULTI_LAUNCH
    for (int ph = 0; ph < N_PHASES; ++ph) { a.ph_lo = ph; a.ph_hi = ph + 1; hipLaunchKernelGGL(fwd_kernel, dim3(grid), dim3(NT), LDS_BYTES, stream, a); }
#else
    a.ph_lo = 0; a.ph_hi = N_PHASES;
    void* args[] = {&a};
    hipError_t e = hipLaunchCooperativeKernel((const void*)fwd_kernel, dim3(grid), dim3(NT), args, LDS_BYTES, stream);
    if (e != hipSuccess) fprintf(stderr, "cooperative launch failed: %s (grid %d)\n", hipGetErrorString(e), grid);
#endif
}
```

```cpp
#include <hip/hip_runtime.h>
#include <hip/hip_cooperative_groups.h>
#include <cstdio>
#include <cstdint>
#include <cmath>
namespace cg = cooperative_groups;
namespace pg8 {
#define PG8_LAS __attribute__((address_space(3)))
typedef unsigned short bf16_t;
typedef short bf16x8 __attribute__((ext_vector_type(8)));
typedef float f32x4 __attribute__((ext_vector_type(4)));
typedef unsigned u32x4 __attribute__((ext_vector_type(4)));
constexpr int BM = 256, BK = 64, HALF = 128, HTB = HALF * BK * 2  , STAGE_BYTES = 8 * HTB, NXCD = 8, WGM = 8;

__host__ __device__ __forceinline__ int lds_byte(int r, int c) { const int st = (r >> 4) * 2 + (c >> 5), rr = r & 15, cc = c & 31, ob = rr * 64 + cc * 2; return st * 1024 + (ob ^ (((ob >> 9) & 1) << 5)); }
__host__ __device__ __forceinline__ void stage_rc(int b, int& R, int& C) { const int st = b / 1024, sb = b % 1024, swz = sb ^ (((sb >> 9) & 1) << 5); R = (st >> 1) * 16 + swz / 64; C = (st & 1) * 32 + (swz % 64) / 2; }
__host__ __device__ __forceinline__ int perm32(int rho) { const int n = rho >> 4, i = rho & 15; return 8 * (i >> 2) + 4 * n + (i & 3); }

struct Unit { int pm, pn; };
struct Gemm { const bf16_t* A; const bf16_t* Bt; int M, N, K; };

struct StaticOrder {
    int nM, nN, nwg, G, c;
    __host__ __device__ void init(int M, int N, int G_, int c_) { nM = M / BM; nN = N / BM; nwg = nM * nN; G = G_; c = c_; }
    __host__ __device__ bool next(int i, Unit& u) const {
        const long L = (long)i * G + c; if (L >= nwg) return false;
        int wgid = (int)L; { const int q = nwg / NXCD, r = nwg % NXCD, xcd = wgid % NXCD, off = wgid / NXCD; wgid = (xcd < r ? xcd * (q + 1) : r * (q + 1) + (xcd - r) * q) + off; }
        const int nig = WGM * nN, gid = wgid / nig, fm = gid * WGM, gsz = (nM - fm) < WGM ? (nM - fm) : WGM;
        u.pm = fm + ((wgid % nig) % gsz); u.pn = (wgid % nig) / gsz; return true;
    }
    __device__ __forceinline__ void a_ready(const Unit&) const {}
    __device__ __forceinline__ void done(const Unit&) const {}
};


__device__ __forceinline__ unsigned cvt_pk_bf16(float lo, float hi) { unsigned r; asm volatile("v_cvt_pk_bf16_f32 %0, %1, %2" : "=v"(r) : "v"(lo), "v"(hi)); return r; }
struct EpiOut {
    static constexpr bool PERM = true, AFTER_DRAIN = false;
    bf16_t* O; int ldc; int act;
    __device__ __forceinline__ void operator()(const f32x4 (&acc)[2][2][4][2], const Unit& u, int wr, int wc, int fr, int fq) const {
        const int row0 = u.pm * BM + wr * 64 + fr; const int col0 = u.pn * BM + wc * 32 + 8 * fq;
#pragma unroll
        for (int ai = 0; ai < 2; ++ai)
#pragma unroll
            for (int m = 0; m < 4; ++m) { bf16_t* rowp = O + (size_t)(row0 + ai * HALF + m * 16) * ldc + col0;
#pragma unroll
                for (int bj = 0; bj < 2; ++bj) { f32x4 v0 = acc[ai][bj][m][0], v1 = acc[ai][bj][m][1];
                    if (act) {
#pragma unroll
                        for (int e = 0; e < 4; ++e) { float a = fmaxf(v0[e], 0.f), b = fmaxf(v1[e], 0.f); v0[e] = a * a; v1[e] = b * b; } }
                    u32x4 w; w.x = cvt_pk_bf16(v0[0], v0[1]); w.y = cvt_pk_bf16(v0[2], v0[3]); w.z = cvt_pk_bf16(v1[0], v1[1]); w.w = cvt_pk_bf16(v1[2], v1[3]);
                    *(u32x4*)(rowp + bj * HALF) = w; } }
    }
};

template <class Epi, class Sched, bool ALIGN_EPI = false, bool SP2 = false>
__device__ __forceinline__ void gemm_phase(PG8_LAS unsigned char* lds, const Gemm g, const Sched& S, const Epi& E) {
    const int tid = threadIdx.x, wid = __builtin_amdgcn_readfirstlane(tid >> 6), lane = tid & 63, wr = wid >> 2, wc = wid & 3, fr = lane & 15, fq = lane >> 4;
    const int K = g.K, nt = K / BK;
    unsigned voffA[2], voffB[2];
#pragma unroll
    for (int i = 0; i < 2; ++i) { int R, C; stage_rc(tid * 16 + i * 8192, R, C); const int Rb = Epi::PERM ? ((R & ~31) + perm32(R & 31)) : R;
        voffA[i] = (unsigned)(R * K + C) * 2u; voffB[i] = (unsigned)(Rb * K + C) * 2u; }
    const size_t kstep = (size_t)(BK * 2);
    const size_t hstep = (size_t)HALF * K * 2;
    const size_t tstep = 2 * hstep;
    const unsigned ldsw = (unsigned)wid * 1024u;
    const int aoff = lds_byte(wr * 64 + fr, fq * 8), boff = lds_byte(wc * 32 + fr, fq * 8);
#define PG8_SA(b, h) (((b) * 2 + (h)) * HTB)
#define PG8_SB(b, h) ((4 + (b) * 2 + (h)) * HTB)
#define PG8_STAGE(bufoff, gbase, voff) do { _Pragma("unroll") for (int _i = 0; _i < 2; ++_i) \
        __builtin_amdgcn_global_load_lds((const unsigned*)((const char*)(gbase) + (voff)[_i]), (PG8_LAS unsigned*)(lds + (bufoff) + ldsw + _i * 8192), 16, 0, 0); } while (0)
#define PG8_LDA(dst, b, h) do { _Pragma("unroll") for (int m = 0; m < 4; ++m) _Pragma("unroll") for (int k = 0; k < 2; ++k) dst[m][k] = *(const PG8_LAS bf16x8*)(lds + PG8_SA(b, h) + aoff + m * 2048 + k * 1024); } while (0)
#define PG8_LDB(dst, b, h) do { _Pragma("unroll") for (int n = 0; n < 2; ++n) _Pragma("unroll") for (int k = 0; k < 2; ++k) dst[n][k] = *(const PG8_LAS bf16x8*)(lds + PG8_SB(b, h) + boff + n * 2048 + k * 1024); } while (0)
#define PG8_MMA(ai, bj, At, Bt) do { __builtin_amdgcn_s_setprio(1); _Pragma("unroll") for (int m = 0; m < 4; ++m) _Pragma("unroll") for (int n = 0; n < 2; ++n) _Pragma("unroll") for (int k = 0; k < 2; ++k) \
        acc[ai][bj][m][n] = __builtin_amdgcn_mfma_f32_16x16x32_bf16(Bt[n][k], At[m][k], acc[ai][bj][m][n], 0, 0, 0); __builtin_amdgcn_s_setprio(0); } while (0)
#define PG8_WAIT_V(n) asm volatile("s_waitcnt vmcnt(" #n ")" ::: "memory")
#define PG8_WAIT_L(n) asm volatile("s_waitcnt lgkmcnt(" #n ")" ::: "memory")
#define PG8_BAR __builtin_amdgcn_s_barrier()
#define PG8_SCHED __builtin_amdgcn_sched_barrier(0)
    Unit cur, nxt; int ui = 0;
    if (!S.next(0, cur)) return;
    f32x4 acc[2][2][4][2];
#pragma unroll
    for (int a = 0; a < 2; ++a)
#pragma unroll
        for (int b = 0; b < 2; ++b)
#pragma unroll
            for (int m = 0; m < 4; ++m)
#pragma unroll
                for (int n = 0; n < 2; ++n) acc[a][b][m][n] = (f32x4){0.f, 0.f, 0.f, 0.f};
    bf16x8 At[4][2], B0[2][2], B1[2][2];
    const char* cA = (const char*)g.A + (size_t)cur.pm * tstep; const char* cB = (const char*)g.Bt + (size_t)cur.pn * tstep;
    S.a_ready(cur);
    if constexpr (SP2) {
        PG8_STAGE(PG8_SB(0, 0), cB, voffB); PG8_STAGE(PG8_SB(0, 1), cB + hstep, voffB); PG8_STAGE(PG8_SA(0, 0), cA, voffA); PG8_STAGE(PG8_SA(0, 1), cA + hstep, voffA);
        if (wr == 1) PG8_BAR;
        PG8_WAIT_V(2); PG8_BAR;
        PG8_STAGE(PG8_SB(1, 0), cB + kstep, voffB); PG8_STAGE(PG8_SA(1, 0), cA + kstep, voffA); PG8_STAGE(PG8_SB(1, 1), cB + hstep + kstep, voffB);
        PG8_WAIT_V(6); PG8_BAR;
    } else {
        PG8_STAGE(PG8_SB(0, 0), cB, voffB); PG8_STAGE(PG8_SA(0, 0), cA, voffA); PG8_STAGE(PG8_SB(0, 1), cB + hstep, voffB); PG8_STAGE(PG8_SA(0, 1), cA + hstep, voffA);
        if (wr == 1) PG8_BAR;
        PG8_WAIT_V(4); PG8_BAR;
        PG8_STAGE(PG8_SB(1, 0), cB + kstep, voffB); PG8_STAGE(PG8_SA(1, 0), cA + kstep, voffA); PG8_STAGE(PG8_SB(1, 1), cB + hstep + kstep, voffB);
        PG8_WAIT_V(6); PG8_BAR;
    }
    for (;;) {
        const bool has_next = S.next(ui + 1, nxt);
        const char* nA = has_next ? (const char*)g.A + (size_t)nxt.pm * tstep : cA; const char* nB = has_next ? (const char*)g.Bt + (size_t)nxt.pn * tstep : cB;
        for (int t = 0; t < nt; t += 2) {
            const bool last = (t == nt - 2);
            const char* a1 = cA + (size_t)(t + 1) * kstep;
            const char* a2 = last ? nA : cA + (size_t)(t + 2) * kstep; const char* b2 = last ? nB : cB + (size_t)(t + 2) * kstep;
            const char* a3 = a2 + kstep; const char* b3 = b2 + kstep;
            if (last && has_next) S.a_ready(nxt);
            if constexpr (SP2) {
            PG8_LDB(B0, 0, 0); PG8_LDB(B1, 0, 1); PG8_SCHED; PG8_LDA(At, 0, 0); PG8_STAGE(PG8_SA(1, 1), a1 + hstep, voffA);
            PG8_WAIT_V(8); PG8_WAIT_L(0); PG8_BAR; PG8_MMA(0, 0, At, B0); PG8_MMA(0, 1, At, B1); PG8_BAR; PG8_SCHED;
            PG8_LDA(At, 0, 1); PG8_STAGE(PG8_SB(0, 0), b2, voffB); PG8_STAGE(PG8_SB(0, 1), b2 + hstep, voffB); PG8_STAGE(PG8_SA(0, 0), a2, voffA);
            PG8_WAIT_V(8); PG8_WAIT_L(0); PG8_BAR; PG8_MMA(1, 0, At, B0); PG8_MMA(1, 1, At, B1); PG8_BAR; PG8_SCHED;
            PG8_LDB(B0, 1, 0); PG8_LDB(B1, 1, 1); PG8_SCHED; PG8_LDA(At, 1, 0); PG8_STAGE(PG8_SA(0, 1), a2 + hstep, voffA);
            PG8_WAIT_V(8); PG8_WAIT_L(0); PG8_BAR; PG8_MMA(0, 0, At, B0); PG8_MMA(0, 1, At, B1); PG8_BAR; PG8_SCHED;
            PG8_LDA(At, 1, 1); PG8_STAGE(PG8_SB(1, 0), b3, voffB); PG8_STAGE(PG8_SB(1, 1), b3 + hstep, voffB); PG8_STAGE(PG8_SA(1, 0), a3, voffA);
            PG8_WAIT_V(8); PG8_WAIT_L(0); PG8_BAR; PG8_MMA(1, 0, At, B0); PG8_MMA(1, 1, At, B1); PG8_BAR; PG8_SCHED;
            } else {
            PG8_LDB(B0, 0, 0); PG8_SCHED; PG8_LDA(At, 0, 0); PG8_STAGE(PG8_SA(1, 1), a1 + hstep, voffA);
            PG8_WAIT_L(8); PG8_BAR; PG8_WAIT_L(0); PG8_MMA(0, 0, At, B0); PG8_BAR; PG8_SCHED;
            PG8_LDB(B1, 0, 1); PG8_STAGE(PG8_SB(0, 0), b2, voffB);
            PG8_BAR; PG8_WAIT_L(0); PG8_MMA(0, 1, At, B1); PG8_BAR;
            PG8_LDA(At, 0, 1); PG8_STAGE(PG8_SA(0, 0), a2, voffA);
            PG8_BAR; PG8_WAIT_L(0); PG8_MMA(1, 0, At, B0); PG8_BAR; PG8_SCHED;
            PG8_STAGE(PG8_SB(0, 1), b2 + hstep, voffB);
            PG8_WAIT_V(6); PG8_BAR; PG8_MMA(1, 1, At, B1); PG8_BAR;
            PG8_LDB(B0, 1, 0); PG8_SCHED; PG8_LDA(At, 1, 0); PG8_STAGE(PG8_SA(0, 1), a2 + hstep, voffA);
            PG8_WAIT_L(8); PG8_BAR; PG8_WAIT_L(0); PG8_MMA(0, 0, At, B0); PG8_BAR; PG8_SCHED;
            PG8_LDB(B1, 1, 1); PG8_STAGE(PG8_SB(1, 0), b3, voffB);
            PG8_BAR; PG8_WAIT_L(0); PG8_MMA(0, 1, At, B1); PG8_BAR;
            PG8_LDA(At, 1, 1); PG8_STAGE(PG8_SA(1, 0), a3, voffA);
            PG8_BAR; PG8_WAIT_L(0); PG8_MMA(1, 0, At, B0); PG8_BAR; PG8_SCHED;
            PG8_STAGE(PG8_SB(1, 1), b3 + hstep, voffB);
            PG8_WAIT_V(6); PG8_BAR; PG8_MMA(1, 1, At, B1); PG8_BAR;
            }
        }
        if constexpr (ALIGN_EPI) { if (wr == 0) PG8_BAR; }
        if constexpr (!Epi::AFTER_DRAIN) { E(acc, cur, wr, wc, fr, fq); S.done(cur); }
        if (!has_next) break;
#pragma unroll
        for (int a = 0; a < 2; ++a)
#pragma unroll
            for (int b = 0; b < 2; ++b)
#pragma unroll
                for (int m = 0; m < 4; ++m)
#pragma unroll
                    for (int n = 0; n < 2; ++n) acc[a][b][m][n] = (f32x4){0.f, 0.f, 0.f, 0.f};
        cur = nxt; cA = nA; cB = nB; ++ui;
        if constexpr (ALIGN_EPI) { if (wr == 1) PG8_BAR; }
    }
    PG8_WAIT_V(0);
    if constexpr (!ALIGN_EPI) { if (wr == 0) PG8_BAR; }
    PG8_BAR;
    if constexpr (Epi::AFTER_DRAIN) { E.fused(acc, cur, wr, wc, fr, fq, lds, wid, lane); S.done(cur); }
#undef PG8_SA
#undef PG8_SB
#undef PG8_STAGE
#undef PG8_LDA
#undef PG8_LDB
#undef PG8_MMA
#undef PG8_WAIT_V
#undef PG8_WAIT_L
#undef PG8_BAR
#undef PG8_SCHED
}
}

#define LAS __attribute__((address_space(3)))
typedef unsigned short bf16;
typedef short bf16x8 __attribute__((ext_vector_type(8)));
typedef float f32x4 __attribute__((ext_vector_type(4)));
typedef unsigned u32x4 __attribute__((ext_vector_type(4)));
typedef unsigned u32x2 __attribute__((ext_vector_type(2)));
constexpr int NWAVES = 8, NT = 512;
constexpr int BATCH = 4, SEQ = 8192, DM = 1024, M = BATCH * SEQ, DEPTH = 2;
constexpr int NC = SEQ / 64, AH = 6, RH = 6, CW = 256, CK = 31;
constexpr int DIN = 3200, DINP = 3328, DFF = 4096;
constexpr int U_AQ = 0, U_AK = 384, U_AV = 768, U_CA = 1152, U_CG = 1408, U_RQ = 1664, U_RK = 2048, U_RV = 2432, U_RG = 2816;
constexpr int Y_ATT = 0, Y_CONV = 384, Y_RET = 640;
constexpr float EPS = 1e-6f, LOG2E = 1.4426950408889634f;
constexpr size_t MiB = 1u << 20;
constexpr size_t WS_ROPE = 1 * MiB;
constexpr size_t WS_WIN = 4 * MiB;
constexpr size_t WS_WOUT = 17 * MiB;
constexpr size_t WS_WUP = 21 * MiB;
constexpr size_t WS_WDN = 37 * MiB;
constexpr size_t WS_H = 54 * MiB;
constexpr size_t WS_MIX = 118 * MiB;
constexpr size_t WS_KV = 118 * MiB;
constexpr size_t WS_ST = 182 * MiB;
constexpr size_t WS_U = 240 * MiB;
constexpr size_t WS_YMIX = 448 * MiB;
constexpr size_t WS_F1 = 240 * MiB;
constexpr size_t WS_END = 512 * MiB;
constexpr int LDS_BYTES = 147456;

__device__ __forceinline__ float bflo(unsigned w) { return __uint_as_float(w << 16); }
__device__ __forceinline__ float bfhi(unsigned w) { return __uint_as_float(w & 0xffff0000u); }
__device__ __forceinline__ unsigned pk2(float lo, float hi) { return pg8::cvt_pk_bf16(lo, hi); }
__device__ __forceinline__ float wave_sum(float v) {
#pragma unroll
    for (int o = 1; o < 64; o <<= 1) v += __shfl_xor(v, o);
    return v;
}
__device__ __forceinline__ float fexp2(float x) { return __builtin_amdgcn_exp2f(x); }
__device__ __forceinline__ float sigmoidf_(float x) { return __builtin_amdgcn_rcpf(1.f + fexp2(-x * LOG2E)); }
#define LDS_BARRIER() do { asm volatile("s_waitcnt lgkmcnt(0)" ::: "memory"); __builtin_amdgcn_s_barrier(); asm volatile("" ::: "memory"); } while (0)
#define MFMA16(a, b, c) __builtin_amdgcn_mfma_f32_16x16x32_bf16((a), (b), (c), 0, 0, 0)

struct Args {
    const float* x; const float* g_mix_pre; const float* g_mix_post; const float* g_mlp_pre; const float* g_mlp_post;
    const float* w_in; const float* rel_bias; const float* conv_w; const float* conv_b; const float* conv_ln_g; const float* conv_ln_b;
    const float* w_out; const float* w_up; const float* w_down;
    float* out; unsigned char* ws;
    int ph_lo, ph_hi;
};

__device__ __forceinline__ void transpose_item(const float* W, int K, int N, bf16* WT, LAS float* scr, int item, int lane) {
    const int nblk = N / 32, kb = item / nblk, nb = item % nblk, k0 = 64 * kb, n0 = 32 * nb;
#pragma unroll 8
    for (int i = 0; i < 32; ++i) { const int kk = 2 * i + (lane >> 5); scr[kk * 33 + (lane & 31)] = W[(size_t)(k0 + kk) * N + n0 + (lane & 31)]; }
    asm volatile("s_waitcnt lgkmcnt(0)" ::: "memory");
    const int c = lane & 7;
#pragma unroll
    for (int j = 0; j < 4; ++j) { const int n = (lane >> 3) + 8 * j; const LAS float* s = scr + (8 * c) * 33 + n;
        u32x4 o; o.x = pk2(s[0 * 33], s[1 * 33]); o.y = pk2(s[2 * 33], s[3 * 33]); o.z = pk2(s[4 * 33], s[5 * 33]); o.w = pk2(s[6 * 33], s[7 * 33]);
        *(u32x4*)(WT + (size_t)(n0 + n) * K + k0 + 8 * c) = o; }
    asm volatile("s_waitcnt lgkmcnt(0)" ::: "memory");
}
__device__ __forceinline__ void rms_row_to_bf16(const float* xrow, const float* g, bf16* orow, int lane) {
    const f32x4* xr = (const f32x4*)xrow + lane; const f32x4* gr = (const f32x4*)g + lane;
    f32x4 v[4]; float s = 0.f;
#pragma unroll
    for (int j = 0; j < 4; ++j) { v[j] = xr[64 * j]; s += (v[j].x * v[j].x + v[j].y * v[j].y) + (v[j].z * v[j].z + v[j].w * v[j].w); }
    const float r = rsqrtf(wave_sum(s) * (1.f / DM) + EPS);
    u32x2* o8 = (u32x2*)orow + lane;
#pragma unroll
    for (int j = 0; j < 4; ++j) { const f32x4 gg = gr[64 * j]; u32x2 w; w.x = pk2(v[j].x * r * gg.x, v[j].y * r * gg.y); w.y = pk2(v[j].z * r * gg.z, v[j].w * r * gg.w); o8[64 * j] = w; }
}
__device__ __forceinline__ void prologue(const Args& a, LAS unsigned char* lds, int gw, int NGW, int wave, int lane) {
    unsigned char* ws = a.ws;
    LAS float* scr = (LAS float*)(lds + wave * 16384);
    constexpr int I_IN = (DM / 64) * (DIN / 32), I_OUT = (DM / 64) * (DM / 32), I_UP = (DM / 64) * (DFF / 32), I_DN = (DFF / 64) * (DM / 32);
    constexpr int PER_L = I_IN + I_OUT + I_UP + I_DN;
    for (int it = gw; it < DEPTH * PER_L; it += NGW) {
        const int l = it / PER_L; int r = it % PER_L;
        if (r < I_IN) { transpose_item(a.w_in + (size_t)l * DM * DIN, DM, DIN, (bf16*)(ws + WS_WIN) + (size_t)l * DINP * DM, scr, r, lane); continue; } r -= I_IN;
        if (r < I_OUT) { transpose_item(a.w_out + (size_t)l * DM * DM, DM, DM, (bf16*)(ws + WS_WOUT) + (size_t)l * DM * DM, scr, r, lane); continue; } r -= I_OUT;
        if (r < I_UP) { transpose_item(a.w_up + (size_t)l * DM * DFF, DM, DFF, (bf16*)(ws + WS_WUP) + (size_t)l * DFF * DM, scr, r, lane); continue; } r -= I_UP;
        transpose_item(a.w_down + (size_t)l * DFF * DM, DFF, DM, (bf16*)(ws + WS_WDN) + (size_t)l * DM * DFF, scr, r, lane);
    }
    for (int i = gw * 64 + lane; i < DEPTH * 16384; i += NGW * 64) { const int l = i / 16384, r = i % 16384;
        ((u32x4*)((bf16*)(ws + WS_WIN) + ((size_t)l * DINP + DIN) * DM))[r] = (u32x4){0u, 0u, 0u, 0u}; }
    float* ct = (float*)(ws + WS_ROPE); float* st = ct + SEQ * 32;
    for (int i = gw * 64 + lane; i < SEQ * 32; i += NGW * 64) { const int s = i >> 5, k = i & 31;
        const float lin = (k == 31) ? 1.0f : (float)k * (1.0f / 31.0f); const float invf = 1.0f / exp2f(lin * 13.287712379549449f); const float ang = (float)s * invf; double t = (double)ang * 0.15915494309189535; t -= rint(t); const float tf = (float)t;
        ct[i] = __builtin_amdgcn_cosf(tf); st[i] = __builtin_amdgcn_sinf(tf); }
    for (int m = gw; m < M; m += NGW) rms_row_to_bf16(a.x + (size_t)m * DM, a.g_mix_pre, (bf16*)(ws + WS_H) + (size_t)m * DM, lane);
}

__device__ __forceinline__ void ephase(const float* xold, const bf16* y, const float* ga, const float* gb, float* xout, bf16* hout, int gw, int NGW, int lane) {
    for (int m = gw; m < M; m += NGW) {
        const f32x4* xr = (const f32x4*)(xold + (size_t)m * DM) + lane; const u32x2* yr = (const u32x2*)(y + (size_t)m * DM) + lane;
        f32x4 xv[4], yv[4]; float s = 0.f;
#pragma unroll
        for (int j = 0; j < 4; ++j) { xv[j] = xr[64 * j]; const u32x2 w = yr[64 * j]; yv[j] = (f32x4){bflo(w.x), bfhi(w.x), bflo(w.y), bfhi(w.y)};
            s += (yv[j].x * yv[j].x + yv[j].y * yv[j].y) + (yv[j].z * yv[j].z + yv[j].w * yv[j].w); }
        const float r1 = rsqrtf(wave_sum(s) * (1.f / DM) + EPS); float s2 = 0.f;
        f32x4* xo = (f32x4*)(xout + (size_t)m * DM) + lane;
#pragma unroll
        for (int j = 0; j < 4; ++j) { const f32x4 gg = ((const f32x4*)ga)[lane + 64 * j]; xv[j] = xv[j] + yv[j] * r1 * gg; xo[64 * j] = xv[j];
            s2 += (xv[j].x * xv[j].x + xv[j].y * xv[j].y) + (xv[j].z * xv[j].z + xv[j].w * xv[j].w); }
        if (gb) { const float r2 = rsqrtf(wave_sum(s2) * (1.f / DM) + EPS); u32x2* ho = (u32x2*)(hout + (size_t)m * DM) + lane;
#pragma unroll
            for (int j = 0; j < 4; ++j) { const f32x4 gg = ((const f32x4*)gb)[lane + 64 * j]; u32x2 w; w.x = pk2(xv[j].x * r2 * gg.x, xv[j].y * r2 * gg.y); w.y = pk2(xv[j].z * r2 * gg.z, xv[j].w * r2 * gg.w); ho[64 * j] = w; } }
    }
}

constexpr int VTS = 72;
__device__ __forceinline__ void scatter8(LAS bf16* T, int row0, int col, u32x4 v) {
    T[(row0 + 0) * VTS + col] = (bf16)(v.x & 0xffffu); T[(row0 + 1) * VTS + col] = (bf16)(v.x >> 16);
    T[(row0 + 2) * VTS + col] = (bf16)(v.y & 0xffffu); T[(row0 + 3) * VTS + col] = (bf16)(v.y >> 16);
    T[(row0 + 4) * VTS + col] = (bf16)(v.z & 0xffffu); T[(row0 + 5) * VTS + col] = (bf16)(v.z >> 16);
    T[(row0 + 6) * VTS + col] = (bf16)(v.w & 0xffffu); T[(row0 + 7) * VTS + col] = (bf16)(v.w >> 16);
}
__device__ __forceinline__ bf16x8 ld_tr_pair(const LAS bf16* T, int row, int col_lo, int col_hi) {
    const u32x2 lo = *(const LAS u32x2*)(T + row * VTS + col_lo), hi = *(const LAS u32x2*)(T + row * VTS + col_hi);
    const u32x4 w = (u32x4){lo.x, lo.y, hi.x, hi.y}; return __builtin_bit_cast(bf16x8, w);
}
__device__ __forceinline__ bf16x8 pack_p(const f32x4 a, const f32x4 b) {
    const u32x4 w = (u32x4){pk2(a[0], a[1]), pk2(a[2], a[3]), pk2(b[0], b[1]), pk2(b[2], b[3])}; return __builtin_bit_cast(bf16x8, w);
}
__device__ __forceinline__ void attn_unit(LAS unsigned char* lds, const bf16* u, const float* relb, bf16* ymix, int b, int n, int hp, int tid, int wid, int lane) {
    const int fr = lane & 15, fq = lane >> 4;
    LAS bf16* Vt0 = (LAS bf16*)lds;
    LAS float* bl = (LAS float*)(lds + 2 * 128 * VTS * 2);
    const int hl = wid >> 2, qg = wid & 3, head = 2 * hp + hl;
    const size_t tok_q = (size_t)b * SEQ + n * 64 + qg * 16 + fr;
    const int c0 = n >= 8 ? 0 : 8 - n;
    const int key = tid >> 3, d0 = (tid & 7) * 16;
    const bf16* vsrc = u + ((size_t)b * SEQ + (size_t)(n + c0 - 8) * 64 + key) * DINP + U_AV + (2 * hp) * 64 + d0;
    const bf16* ksrc = u + ((size_t)b * SEQ + (size_t)(n + c0 - 8) * 64 + fr) * DINP + U_AK + head * 64 + 8 * fq;
    u32x4 v0 = *(const u32x4*)vsrc, v1 = *(const u32x4*)(vsrc + 8);
    bf16x8 Kc[4][2];
#pragma unroll
    for (int kt = 0; kt < 4; ++kt)
#pragma unroll
        for (int ks = 0; ks < 2; ++ks) Kc[kt][ks] = *(const bf16x8*)(ksrc + (size_t)kt * 16 * DINP + ks * 32);
    bf16x8 Qb[2];
#pragma unroll
    for (int ks = 0; ks < 2; ++ks) Qb[ks] = *(const bf16x8*)(u + tok_q * DINP + U_AQ + head * 64 + ks * 32 + 8 * fq);
    LDS_BARRIER();
    for (int i = tid; i < 2 * 257; i += NT) { const int h2 = i / 257, k = i % 257; bl[h2 * 260 + k] = relb[(2 * hp + h2) * 257 + k]; }
    float m_run = -1e30f, l_run = 0.f; f32x4 O[4];
#pragma unroll
    for (int dt = 0; dt < 4; ++dt) O[dt] = (f32x4){0.f, 0.f, 0.f, 0.f};
    for (int c = c0; c <= 8; ++c) {
        LAS bf16* Vt = Vt0 + (c & 1) * 128 * VTS;
        scatter8(Vt, d0, key, v0); scatter8(Vt, d0 + 8, key, v1);
        f32x4 st[4];
#pragma unroll
        for (int kt = 0; kt < 4; ++kt) { st[kt] = (f32x4){0.f, 0.f, 0.f, 0.f};
#pragma unroll
            for (int ks = 0; ks < 2; ++ks) st[kt] = MFMA16(Kc[kt][ks], Qb[ks], st[kt]); }
        if (c < 8) { vsrc += (size_t)64 * DINP; ksrc += (size_t)64 * DINP;
            v0 = *(const u32x4*)vsrc; v1 = *(const u32x4*)(vsrc + 8);
#pragma unroll
            for (int kt = 0; kt < 4; ++kt)
#pragma unroll
                for (int ks = 0; ks < 2; ++ks) Kc[kt][ks] = *(const bf16x8*)(ksrc + (size_t)kt * 16 * DINP + ks * 32); }
        LDS_BARRIER();
        float mx = -1e30f;
        if (c >= 6) { const int relbase = (qg * 16 + fr) + 64 * (8 - c);
#pragma unroll
            for (int kt = 0; kt < 4; ++kt)
#pragma unroll
                for (int r = 0; r < 4; ++r) { const int rel = relbase - (kt * 16 + 4 * fq + r); const int idx = (rel < 128 ? rel : 128) + 128;
                    const float sv = st[kt][r] * 0.125f + bl[hl * 260 + idx]; st[kt][r] = sv; mx = fmaxf(mx, sv); }
        } else { const float bc = bl[hl * 260 + 256];
#pragma unroll
            for (int kt = 0; kt < 4; ++kt)
#pragma unroll
                for (int r = 0; r < 4; ++r) { const float sv = st[kt][r] * 0.125f + bc; st[kt][r] = sv; mx = fmaxf(mx, sv); } }
        mx = fmaxf(mx, __shfl_xor(mx, 16)); mx = fmaxf(mx, __shfl_xor(mx, 32));
        const float m_new = fmaxf(m_run, mx), alpha = fexp2((m_run - m_new) * LOG2E); float psum = 0.f;
        const float mb = m_new * LOG2E;
#pragma unroll
        for (int kt = 0; kt < 4; ++kt)
#pragma unroll
            for (int r = 0; r < 4; ++r) { const float p = fexp2(st[kt][r] * LOG2E - mb); st[kt][r] = p; psum += p; }
        psum += __shfl_xor(psum, 16); psum += __shfl_xor(psum, 32);
        l_run = l_run * alpha + psum; m_run = m_new;
#pragma unroll
        for (int dt = 0; dt < 4; ++dt) O[dt] = O[dt] * alpha;
#pragma unroll
        for (int kk = 0; kk < 2; ++kk) { const bf16x8 pb = pack_p(st[2 * kk], st[2 * kk + 1]);
#pragma unroll
            for (int dt = 0; dt < 4; ++dt) { const bf16x8 Va = ld_tr_pair(Vt, hl * 64 + dt * 16 + fr, 32 * kk + 4 * fq, 32 * kk + 16 + 4 * fq); O[dt] = MFMA16(Va, pb, O[dt]); } }
    }
    const float inv = 1.f / l_run;
#pragma unroll
    for (int dt = 0; dt < 4; ++dt) { u32x2 w; w.x = pk2(O[dt][0] * inv, O[dt][1] * inv); w.y = pk2(O[dt][2] * inv, O[dt][3] * inv);
        *(u32x2*)(ymix + tok_q * DM + Y_ATT + head * 64 + dt * 16 + 4 * fq) = w; }
}

__device__ __forceinline__ void conv_unit(LAS unsigned char* lds, const bf16* u, const float* cw, const float* cb, const float* lng, const float* lnb, bf16* ymix, int b, int n, int tid, int wid, int lane) {
    LAS float* yb = (LAS float*)lds;
    __syncthreads();
    for (int i = tid; i < 94 * 32; i += NT) { const int tt = i >> 5, cgp = i & 31; const int t = n * 64 - 30 + tt;
        f32x4 o0 = (f32x4){0.f, 0.f, 0.f, 0.f}, o1 = o0;
        if (t >= 0) { const bf16* src = u + ((size_t)b * SEQ + t) * DINP + U_CA + cgp * 8; const u32x4 av = *(const u32x4*)src, gv = *(const u32x4*)(src + CW);
            o0 = (f32x4){bflo(av.x) * sigmoidf_(bflo(gv.x)), bfhi(av.x) * sigmoidf_(bfhi(gv.x)), bflo(av.y) * sigmoidf_(bflo(gv.y)), bfhi(av.y) * sigmoidf_(bfhi(gv.y))};
            o1 = (f32x4){bflo(av.z) * sigmoidf_(bflo(gv.z)), bfhi(av.z) * sigmoidf_(bfhi(gv.z)), bflo(av.w) * sigmoidf_(bflo(gv.w)), bfhi(av.w) * sigmoidf_(bfhi(gv.w))}; }
        *(LAS f32x4*)(yb + tt * 256 + cgp * 8) = o0; *(LAS f32x4*)(yb + tt * 256 + cgp * 8 + 4) = o1; }
    __syncthreads();
    const int ch = tid & 255, half = tid >> 8;
    float w[CK];
#pragma unroll
    for (int j = 0; j < CK; ++j) w[j] = cw[j * CW + ch];
    float acc[32]; const float bias = cb[ch];
    { float yv[62];
#pragma unroll
      for (int r = 0; r < 62; ++r) yv[r] = yb[(half * 32 + r) * 256 + ch];
#pragma unroll
      for (int i = 0; i < 32; ++i) { float sacc = bias;
#pragma unroll
          for (int j = 0; j < CK; ++j) sacc += w[j] * yv[i + j];
          acc[i] = sacc; } }
    __syncthreads();
#pragma unroll
    for (int i = 0; i < 32; ++i) yb[(half * 32 + i) * 256 + ch] = acc[i];
    __syncthreads();
    const f32x4 gg = ((const f32x4*)lng)[lane], bb = ((const f32x4*)lnb)[lane];
    f32x4 v[8]; float sm[8], sq[8];
#pragma unroll
    for (int k = 0; k < 8; ++k) { v[k] = *(const LAS f32x4*)(yb + (wid * 8 + k) * 256 + 4 * lane); sm[k] = (v[k].x + v[k].y) + (v[k].z + v[k].w); }
#pragma unroll
    for (int o = 1; o < 64; o <<= 1)
#pragma unroll
        for (int k = 0; k < 8; ++k) sm[k] += __shfl_xor(sm[k], o);
#pragma unroll
    for (int k = 0; k < 8; ++k) { v[k] = v[k] - sm[k] * (1.f / 256.f); sq[k] = (v[k].x * v[k].x + v[k].y * v[k].y) + (v[k].z * v[k].z + v[k].w * v[k].w); }
#pragma unroll
    for (int o = 1; o < 64; o <<= 1)
#pragma unroll
        for (int k = 0; k < 8; ++k) sq[k] += __shfl_xor(sq[k], o);
#pragma unroll
    for (int k = 0; k < 8; ++k) { const int t = wid * 8 + k; const float rstd = rsqrtf(sq[k] * (1.f / 256.f) + EPS);
        f32x4 y = v[k] * rstd * gg + bb; y = (f32x4){y.x * sigmoidf_(y.x), y.y * sigmoidf_(y.y), y.z * sigmoidf_(y.z), y.w * sigmoidf_(y.w)};
        u32x2 o; o.x = pk2(y.x, y.y); o.y = pk2(y.z, y.w);
        *(u32x2*)(ymix + ((size_t)b * SEQ + n * 64 + t) * DM + Y_CONV + 4 * lane) = o; }
}

__device__ __forceinline__ float ret_logg2(int h) { return log2f(1.f - exp2f(-5.f - (float)h)); }
__device__ __forceinline__ void rope8(const u32x4 a, const u32x4 c, const float* ct, const float* st, int pos, int dg, float scale, float (&o1)[8], float (&o2)[8]) {
    const f32x4 c0 = *(const f32x4*)(ct + pos * 32 + dg * 8), c1 = *(const f32x4*)(ct + pos * 32 + dg * 8 + 4);
    const f32x4 s0 = *(const f32x4*)(st + pos * 32 + dg * 8), s1 = *(const f32x4*)(st + pos * 32 + dg * 8 + 4);
    const float x1[8] = {bflo(a.x), bfhi(a.x), bflo(a.y), bfhi(a.y), bflo(a.z), bfhi(a.z), bflo(a.w), bfhi(a.w)};
    const float x2[8] = {bflo(c.x), bfhi(c.x), bflo(c.y), bfhi(c.y), bflo(c.z), bfhi(c.z), bflo(c.w), bfhi(c.w)};
    const float cs[8] = {c0.x, c0.y, c0.z, c0.w, c1.x, c1.y, c1.z, c1.w}, sn[8] = {s0.x, s0.y, s0.z, s0.w, s1.x, s1.y, s1.z, s1.w};
#pragma unroll
    for (int e = 0; e < 8; ++e) { o1[e] = (x1[e] * cs[e] - x2[e] * sn[e]) * scale; o2[e] = (x2[e] * cs[e] + x1[e] * sn[e]) * scale; }
}
__device__ __forceinline__ bf16x8 pack8(const float (&o)[8]) { const u32x4 w = (u32x4){pk2(o[0], o[1]), pk2(o[2], o[3]), pk2(o[4], o[5]), pk2(o[6], o[7])}; return __builtin_bit_cast(bf16x8, w); }
__device__ __forceinline__ void stage_vt(LAS bf16* Vt, const bf16* u, size_t tok0, int tid) {
    for (int i = tid; i < 64 * 48; i += NT) { const int j = i / 48, cg8 = i % 48; const u32x4 v = *(const u32x4*)(u + (tok0 + j) * DINP + U_RV + cg8 * 8); scatter8(Vt, cg8 * 8, j, v); }
}
__device__ __forceinline__ void retkv_unit(LAS unsigned char* lds, const bf16* u, const float* ct, const float* st, float* kv, int b, int n, int tid, int wid, int lane) {
    const int fr = lane & 15, fq = lane >> 4;
    LAS bf16* Vt = (LAS bf16*)lds; LAS bf16* Kt = Vt + 384 * VTS;
    const size_t tok0 = (size_t)b * SEQ + n * 64;
    __syncthreads();
    stage_vt(Vt, u, tok0, tid);
    for (int i = tid; i < 64 * 24; i += NT) { const int j = i / 24, r = i % 24, h = r >> 2, dg = r & 3;
        const bf16* src = u + (tok0 + j) * DINP + U_RK + h * 64 + dg * 8; const u32x4 a = *(const u32x4*)src, c = *(const u32x4*)(src + 32);
        float o1[8], o2[8]; rope8(a, c, ct, st, n * 64 + j, dg, 0.125f * fexp2((float)(63 - j) * ret_logg2(h)), o1, o2);
        const u32x4 w1 = (u32x4){pk2(o1[0], o1[1]), pk2(o1[2], o1[3]), pk2(o1[4], o1[5]), pk2(o1[6], o1[7])}, w2 = (u32x4){pk2(o2[0], o2[1]), pk2(o2[2], o2[3]), pk2(o2[4], o2[5]), pk2(o2[6], o2[7])};
        scatter8(Kt, h * 64 + dg * 8, j, w1); scatter8(Kt, h * 64 + 32 + dg * 8, j, w2); }
    __syncthreads();
    for (int t = wid; t < 24; t += NWAVES) { const int h = t >> 2, et = t & 3;
        bf16x8 Va[2];
#pragma unroll
        for (int ks = 0; ks < 2; ++ks) Va[ks] = *(const LAS bf16x8*)(Vt + (h * 64 + et * 16 + fr) * VTS + ks * 32 + 8 * fq);
        float* dst = kv + (((size_t)b * NC + n) * RH + h) * 4096;
#pragma unroll
        for (int dt = 0; dt < 4; ++dt) { f32x4 acc = (f32x4){0.f, 0.f, 0.f, 0.f};
#pragma unroll
            for (int ks = 0; ks < 2; ++ks) { const bf16x8 Kb = *(const LAS bf16x8*)(Kt + (h * 64 + dt * 16 + fr) * VTS + ks * 32 + 8 * fq); acc = MFMA16(Va[ks], Kb, acc); }
#pragma unroll
            for (int r = 0; r < 4; ++r) dst[(et * 16 + 4 * fq + r) * 64 + dt * 16 + fr] = acc[r]; }
    }
}
__device__ __forceinline__ void scan_phase(const float* kv, bf16* state, int gtid, int gthreads) {
    for (int g = gtid; g < BATCH * RH * 4096; g += gthreads) { const int ed = g & 4095, bh = g >> 12, h = bh % RH, b = bh / RH;
        const float gc = fexp2(64.f * ret_logg2(h)); float S = 0.f;
#pragma unroll 8
        for (int n = 0; n < NC; ++n) { const size_t idx = (((size_t)b * NC + n) * RH + h) * 4096 + ed; const float v = kv[idx]; state[idx] = (bf16)(pk2(S, 0.f) & 0xffffu); S = S * gc + v; }
    }
}
__device__ __forceinline__ void retout_unit(LAS unsigned char* lds, const bf16* u, const float* ct, const float* st, const bf16* state, bf16* ymix, int b, int n, int tid, int wid, int lane) {
    const int fr = lane & 15, fq = lane >> 4;
    LAS bf16* Vt = (LAS bf16*)lds;
    const size_t tok0 = (size_t)b * SEQ + n * 64;
    __syncthreads();
    stage_vt(Vt, u, tok0, tid);
    __syncthreads();
    for (int t = wid; t < 24; t += NWAVES) { const int h = t >> 2, ig = t & 3; const float lg2 = ret_logg2(h);
        const size_t tok_i = tok0 + ig * 16 + fr;
        bf16x8 Qb[2];
        { const bf16* src = u + tok_i * DINP + U_RQ + h * 64 + fq * 8; const u32x4 a = *(const u32x4*)src, c = *(const u32x4*)(src + 32);
          float o1[8], o2[8]; rope8(a, c, ct, st, n * 64 + ig * 16 + fr, fq, 1.f, o1, o2); Qb[0] = pack8(o1); Qb[1] = pack8(o2); }
        f32x4 y[4];
        const bf16* sp = state + (((size_t)b * NC + n) * RH + h) * 4096;
        const float xi = fexp2((float)(ig * 16 + fr + 1) * lg2);
#pragma unroll
        for (int et = 0; et < 4; ++et) { y[et] = (f32x4){0.f, 0.f, 0.f, 0.f};
#pragma unroll
            for (int ks = 0; ks < 2; ++ks) { const bf16x8 Sa = *(const bf16x8*)(sp + (et * 16 + fr) * 64 + ks * 32 + 8 * fq); y[et] = MFMA16(Sa, Qb[ks], y[et]); }
            y[et] = y[et] * xi; }
        f32x4 sc[4];
#pragma unroll
        for (int jt = 0; jt < 4; ++jt) { sc[jt] = (f32x4){0.f, 0.f, 0.f, 0.f};
            if (jt <= ig) {
                const bf16* src = u + (tok0 + jt * 16 + fr) * DINP + U_RK + h * 64 + fq * 8; const u32x4 a = *(const u32x4*)src, c = *(const u32x4*)(src + 32);
                float o1[8], o2[8]; rope8(a, c, ct, st, n * 64 + jt * 16 + fr, fq, 0.125f, o1, o2);
                sc[jt] = MFMA16(pack8(o1), Qb[0], sc[jt]); sc[jt] = MFMA16(pack8(o2), Qb[1], sc[jt]);
#pragma unroll
                for (int r = 0; r < 4; ++r) { const int dlt = (ig * 16 + fr) - (jt * 16 + 4 * fq + r); sc[jt][r] = dlt >= 0 ? sc[jt][r] * fexp2((float)dlt * lg2) : 0.f; }
            } }
#pragma unroll
        for (int kk = 0; kk < 2; ++kk) { const bf16x8 pb = pack_p(sc[2 * kk], sc[2 * kk + 1]);
#pragma unroll
            for (int et = 0; et < 4; ++et) { const bf16x8 Va = ld_tr_pair(Vt, h * 64 + et * 16 + fr, 32 * kk + 4 * fq, 32 * kk + 16 + 4 * fq); y[et] = MFMA16(Va, pb, y[et]); } }
        float s = 0.f;
#pragma unroll
        for (int et = 0; et < 4; ++et) s += (y[et][0] + y[et][1]) + (y[et][2] + y[et][3]);
        s += __shfl_xor(s, 16); s += __shfl_xor(s, 32);
        const float mean = s * (1.f / 64.f); float q = 0.f;
#pragma unroll
        for (int et = 0; et < 4; ++et) { y[et] = y[et] - mean; q += (y[et][0] * y[et][0] + y[et][1] * y[et][1]) + (y[et][2] * y[et][2] + y[et][3] * y[et][3]); }
        q += __shfl_xor(q, 16); q += __shfl_xor(q, 32);
        const float rstd = rsqrtf(q * (1.f / 64.f) + EPS);
#pragma unroll
        for (int et = 0; et < 4; ++et) { const u32x2 gw2 = *(const u32x2*)(u + tok_i * DINP + U_RG + h * 64 + et * 16 + 4 * fq);
            const float g0 = bflo(gw2.x), g1 = bfhi(gw2.x), g2 = bflo(gw2.y), g3 = bfhi(gw2.y);
            u32x2 o; o.x = pk2(g0 * sigmoidf_(g0) * y[et][0] * rstd, g1 * sigmoidf_(g1) * y[et][1] * rstd); o.y = pk2(g2 * sigmoidf_(g2) * y[et][2] * rstd, g3 * sigmoidf_(g3) * y[et][3] * rstd);
            *(u32x2*)(ymix + tok_i * DM + Y_RET + h * 64 + et * 16 + 4 * fq) = o; }
    }
}

#define XB_TMO      128
#define XB_XCNT(j)  (256  + 64 * (j))
#define XB_XSUB(j)  (1280 + 64 * (j))
#define XB_XGEN(j)  (2304 + 64 * (j))
#define XB_TOP      3328
#define XB_TOPGEN   3392
#define XCD_BAR_WORDS 3456
#define XB_SPIN_CAP (1u << 18)

__device__ __forceinline__ unsigned xb_ld(unsigned* p)              { return __hip_atomic_load(p, __ATOMIC_RELAXED, __HIP_MEMORY_SCOPE_AGENT); }
__device__ __forceinline__ unsigned xb_add(unsigned* p, unsigned v) { return __hip_atomic_fetch_add(p, v, __ATOMIC_RELAXED, __HIP_MEMORY_SCOPE_AGENT); }
__device__ __forceinline__ unsigned xb_xcc_id() { return (unsigned)__builtin_amdgcn_s_getreg((3 << 11) | 20) & 0xFu; }
#define XB_SPIN(cond, bar) do { unsigned _sp = 0; while (cond) { __builtin_amdgcn_s_sleep(1); \
    if ((++_sp & 255u) == 0u) { if (xb_ld(&(bar)[XB_TMO])) break; if (_sp > XB_SPIN_CAP) { atomicAdd(&(bar)[XB_TMO], 1u); break; } } } } while (0)

struct XcdBarrier {
    unsigned* bar; unsigned x;
    volatile LAS unsigned* st;
};

__device__ __forceinline__ XcdBarrier xcd_barrier_post(unsigned* bar, volatile LAS unsigned* st) {
    XcdBarrier b; b.bar = bar; b.x = xb_xcc_id(); b.st = st;
    if (threadIdx.x == 0) (void)xb_add(&bar[XB_XCNT(b.x)], 1u);
    return b;
}
__device__ __forceinline__ void xcd_barrier_complete(unsigned* bar, unsigned x, unsigned& nloc, unsigned& nx) {
    const unsigned G = gridDim.x * gridDim.y * gridDim.z;
    unsigned sum, cnt, mine, sp = 0u;
    for (;;) {
        sum = 0u; cnt = 0u; mine = 0u;
#pragma unroll
        for (unsigned j = 0; j < 16; ++j) { const unsigned c = xb_ld(&bar[XB_XCNT(j)]); sum += c; cnt += (c > 0u) ? 1u : 0u; mine = (j == x) ? c : mine; }
        if (sum == G) break;
        __builtin_amdgcn_s_sleep(1);
        if ((++sp & 255u) == 0u) { if (xb_ld(&bar[XB_TMO])) break; if (sp > XB_SPIN_CAP) { atomicAdd(&bar[XB_TMO], 1u); break; } }
    }
    nloc = mine > 0u ? mine : 1u; nx = cnt > 0u ? cnt : 1u;
}

__device__ __forceinline__ void xcd_barrier(const XcdBarrier& b) {
    asm volatile("s_waitcnt vmcnt(0)" ::: "memory");
    __syncthreads();
    if (threadIdx.x == 0) {
        unsigned* bar = b.bar;
        __builtin_amdgcn_s_waitcnt(0);
        unsigned nloc = b.st[0], nx = b.st[1];
        if (nloc == 0u) { xcd_barrier_complete(bar, b.x, nloc, nx); b.st[0] = nloc; b.st[1] = nx; }
        const unsigned old = xb_add(&bar[XB_XSUB(b.x)], 1u);
        const unsigned gen = old / nloc;
        if (old + 1u == (gen + 1u) * nloc) {
            __builtin_amdgcn_fence(__ATOMIC_RELEASE, "agent");
            asm volatile("s_waitcnt vmcnt(0)" ::: "memory");
            const unsigned og = xb_add(&bar[XB_TOP], 1u);
            const unsigned tg = og / nx;
            if (og + 1u == (tg + 1u) * nx) xb_add(&bar[XB_TOPGEN], 1u);
            else XB_SPIN(xb_ld(&bar[XB_TOPGEN]) == tg, bar);
            __builtin_amdgcn_fence(__ATOMIC_ACQUIRE, "agent");
            xb_add(&bar[XB_XGEN(b.x)], 1u);
            asm volatile("s_waitcnt vmcnt(0)" ::: "memory");
        } else {
            XB_SPIN(xb_ld(&bar[XB_XGEN(b.x)]) == gen, bar);
            __builtin_amdgcn_fence(__ATOMIC_ACQUIRE, "agent");
            asm volatile("s_waitcnt vmcnt(0)" ::: "memory");
        }
    }
    __syncthreads();
}

#ifndef PROBE
#define PROBE 0
#endif
#define REP(bit) for (int rep_ = 0; rep_ < ((PROBE & (bit)) ? 2 : 1); ++rep_)
constexpr int N_PHASES = 1 + 9 * DEPTH;
#define IN(k) (lo <= (k) && (k) < hi)
#ifdef NO_SYNC
#define SEAM(k) do { } while (0)
#else
#define SEAM(k) do { if (lo <= (k) && (k) + 1 < hi) { REP(32) { xcd_barrier(bar); } } } while (0)
#endif
template <int l> __device__ __forceinline__ void layer_phases(const Args& a, LAS unsigned char* lds, const XcdBarrier& bar, int lo, int hi, int tid, int lane, int wid, int G, int bx, int gw, int NGW) {
    unsigned char* ws = a.ws;
    bf16* Hb = (bf16*)(ws + WS_H); bf16* MIXb = (bf16*)(ws + WS_MIX); bf16* Ub = (bf16*)(ws + WS_U); bf16* YM = (bf16*)(ws + WS_YMIX); bf16* F1 = (bf16*)(ws + WS_F1);
    float* KV = (float*)(ws + WS_KV); bf16* STt = (bf16*)(ws + WS_ST);
    const float* ct = (const float*)(ws + WS_ROPE); const float* st = ct + SEQ * 32;
        const int pb = 1 + 9 * l;
        if (IN(pb + 0)) {
#ifndef NO_GEMM
            const pg8::Gemm g{Hb, (const bf16*)(ws + WS_WIN) + (size_t)l * DINP * DM, M, DINP, DM}; const pg8::EpiOut E{Ub, DINP, 0};
            pg8::StaticOrder S; S.init(M, DINP, G, bx);
            REP(128) pg8::gemm_phase<pg8::EpiOut, pg8::StaticOrder, true, true>(lds, g, S, E);
#endif
        }
        SEAM(pb + 0);
        if (IN(pb + 1)) {
            const float* relb = a.rel_bias + (size_t)l * AH * 257;
            for (int it = bx; it < 1536 + 512 + 512; it += G) {
                if (it < 1536) {
#ifndef NO_ATTN
                    const int hp = it % 3, bn = it / 3; REP(1) attn_unit(lds, Ub, relb, YM, bn / NC, bn % NC, hp, tid, wid, lane);
#endif
                } else if (it < 2048) {
#ifndef NO_CONV
                    const int bn = it - 1536; REP(2) conv_unit(lds, Ub, a.conv_w + (size_t)l * CK * CW, a.conv_b + l * CW, a.conv_ln_g + l * CW, a.conv_ln_b + l * CW, YM, bn / NC, bn % NC, tid, wid, lane);
#endif
                } else {
#ifndef NO_RETKV
                    const int bn = it - 2048; REP(4) retkv_unit(lds, Ub, ct, st, KV, bn / NC, bn % NC, tid, wid, lane);
#endif
                }
            }
        }
        SEAM(pb + 1);
        if (IN(pb + 2)) REP(8) scan_phase(KV, STt, bx * NT + tid, G * NT);
        SEAM(pb + 2);
        if (IN(pb + 3)) {
#ifndef NO_RETOUT
            REP(16) for (int it = bx; it < 512; it += G) retout_unit(lds, Ub, ct, st, STt, YM, it / NC, it % NC, tid, wid, lane);
#endif
        }
        SEAM(pb + 3);
        if (IN(pb + 4)) {
#ifndef NO_GEMM
            const pg8::Gemm g{YM, (const bf16*)(ws + WS_WOUT) + (size_t)l * DM * DM, M, DM, DM}; const pg8::EpiOut E{MIXb, DM, 0};
            pg8::StaticOrder S; S.init(M, DM, G, bx);
            REP(128) pg8::gemm_phase<pg8::EpiOut, pg8::StaticOrder, true, true>(lds, g, S, E);
#endif
        }
        SEAM(pb + 4);
        if (IN(pb + 5)) ephase(l == 0 ? a.x : a.out, MIXb, a.g_mix_post + l * DM, a.g_mlp_pre + l * DM, a.out, Hb, gw, NGW, lane);
        SEAM(pb + 5);
        if (IN(pb + 6)) {
#ifndef NO_GEMM
            const pg8::Gemm g{Hb, (const bf16*)(ws + WS_WUP) + (size_t)l * DFF * DM, M, DFF, DM}; const pg8::EpiOut E{F1, DFF, 1};
            pg8::StaticOrder S; S.init(M, DFF, G, bx);
            REP(128) pg8::gemm_phase<pg8::EpiOut, pg8::StaticOrder, true, true>(lds, g, S, E);
#endif
        }
        SEAM(pb + 6);
        if (IN(pb + 7)) {
#ifndef NO_GEMM
            const pg8::Gemm g{F1, (const bf16*)(ws + WS_WDN) + (size_t)l * DM * DFF, M, DM, DFF}; const pg8::EpiOut E{MIXb, DM, 0};
            pg8::StaticOrder S; S.init(M, DM, G, bx);
            REP(128) pg8::gemm_phase<pg8::EpiOut, pg8::StaticOrder, true, true>(lds, g, S, E);
#endif
        }
        SEAM(pb + 7);
        if (IN(pb + 8)) ephase(a.out, MIXb, a.g_mlp_post + l * DM, (l + 1 < DEPTH) ? a.g_mix_pre + (l + 1) * DM : nullptr, a.out, Hb, gw, NGW, lane);
        SEAM(pb + 8);
    }
__global__ void __launch_bounds__(NT, 2) fwd_kernel(Args a) {
    extern __shared__ __attribute__((aligned(16))) unsigned char lds_raw[];
    LAS unsigned char* lds = (LAS unsigned char*)lds_raw;
    const int tid = threadIdx.x, lane = tid & 63, wid = __builtin_amdgcn_readfirstlane(tid >> 6);
    const int G = gridDim.x, bx = blockIdx.x;
    const int gw = bx * NWAVES + wid, NGW = G * NWAVES;
    unsigned char* ws = a.ws;
    bf16* Hb = (bf16*)(ws + WS_H); bf16* MIXb = (bf16*)(ws + WS_MIX); bf16* Ub = (bf16*)(ws + WS_U); bf16* YM = (bf16*)(ws + WS_YMIX); bf16* F1 = (bf16*)(ws + WS_F1);
    float* KV = (float*)(ws + WS_KV); bf16* STt = (bf16*)(ws + WS_ST);
    const float* ct = (const float*)(ws + WS_ROPE); const float* st = ct + SEQ * 32;
    const int lo = a.ph_lo, hi = a.ph_hi;
    volatile LAS unsigned* stw = (volatile LAS unsigned*)(lds + 131072 + 64);
    unsigned* barw = (unsigned*)ws;
    if (tid < 2) stw[tid] = 0u;
    if (bx == 0) for (int i = tid; i < XCD_BAR_WORDS; i += NT) barw[i] = 0u;
    __syncthreads();
    if (IN(0)) REP(64) prologue(a, lds, gw, NGW, wid, lane);
    __syncthreads(); cg::this_grid().sync();
    const XcdBarrier bar = xcd_barrier_post(barw, stw);
    layer_phases<0>(a, lds, bar, lo, hi, tid, lane, wid, G, bx, gw, NGW);
    layer_phases<1>(a, lds, bar, lo, hi, tid, lane, wid, G, bx, gw, NGW);
}
#undef IN
#undef SEAM


#ifndef MULTI_LAUNCH
#define MULTI_LAUNCH 0
#endif
extern "C" void kernel_launch(void* const* d_in, const int* in_sizes, int n_in, void* d_out, int out_size, void* d_ws, size_t ws_size, hipStream_t stream) {
    static int grid = 0;
    if (grid == 0) {
        if (n_in != 14 || in_sizes[0] != M * DM || out_size != M * DM || ws_size < WS_END) { fprintf(stderr, "kernel_launch: unexpected shapes: n_in %d in0 %d out %d ws %zu\n", n_in, n_in > 0 ? in_sizes[0] : -1, out_size, ws_size); grid = -1; return; }
        int dev = 0, cus = 0, per_cu = 0;
        hipGetDevice(&dev); hipDeviceGetAttribute(&cus, hipDeviceAttributeMultiprocessorCount, dev);
        if (hipFuncSetAttribute((const void*)fwd_kernel, hipFuncAttributeMaxDynamicSharedMemorySize, LDS_BYTES) != hipSuccess) { fprintf(stderr, "kernel_launch: hipFuncSetAttribute failed\n"); grid = -1; return; }
        if (hipOccupancyMaxActiveBlocksPerMultiprocessor(&per_cu, (const void*)fwd_kernel, NT, LDS_BYTES) != hipSuccess || per_cu < 1) { fprintf(stderr, "kernel_launch: occupancy query says %d\n", per_cu); per_cu = 1; }
        (void)hipGetLastError();
        grid = cus * 1;
        fprintf(stderr, "kernel_launch: cus %d per_cu %d grid %d\n", cus, per_cu, grid);
    }
    if (grid < 0) return;
    Args a{};
    a.x = (const float*)d_in[0]; a.g_mix_pre = (const float*)d_in[1]; a.g_mix_post = (const float*)d_in[2]; a.g_mlp_pre = (const float*)d_in[3]; a.g_mlp_post = (const float*)d_in[4];
    a.w_in = (const float*)d_in[5]; a.rel_bias = (const float*)d_in[6]; a.conv_w = (const float*)d_in[7]; a.conv_b = (const float*)d_in[8]; a.conv_ln_g = (const float*)d_in[9]; a.conv_ln_b = (const float*)d_in[10];
    a.w_out = (const float*)d_in[11]; a.w_up = (const float*)d_in[12]; a.w_down = (const float*)d_in[13];
    a.out = (float*)d_out; a.ws = (unsigned char*)d_ws;
#if MULTI_LAUNCH
    for (int ph = 0; ph < N_PHASES; ++ph) { a.ph_lo = ph; a.ph_hi = ph + 1; hipLaunchKernelGGL(fwd_kernel, dim3(grid), dim3(NT), LDS_BYTES, stream, a); }
#else
    a.ph_lo = 0; a.ph_hi = N_PHASES;
    void* args[] = {&a};
    hipError_t e = hipLaunchCooperativeKernel((const void*)fwd_kernel, dim3(grid), dim3(NT), args, LDS_BYTES, stream);
    if (e != hipSuccess) fprintf(stderr, "cooperative launch failed: %s (grid %d)\n", hipGetErrorString(e), grid);
#endif
}
```

```cpp
#include <hip/hip_runtime.h>
#include <hip/hip_cooperative_groups.h>
#include <cstdio>
#include <cstdint>
#include <cmath>
namespace cg = cooperative_groups;
namespace pg8 {
#define PG8_LAS __attribute__((address_space(3)))
typedef unsigned short bf16_t;
typedef short bf16x8 __attribute__((ext_vector_type(8)));
typedef float f32x4 __attribute__((ext_vector_type(4)));
typedef unsigned u32x4 __attribute__((ext_vector_type(4)));
constexpr int BM = 256, BK = 64, HALF = 128, HTB = HALF * BK * 2  , STAGE_BYTES = 8 * HTB, NXCD = 8, WGM = 8;

__host__ __device__ __forceinline__ int lds_byte(int r, int c) { const int st = (r >> 4) * 2 + (c >> 5), rr = r & 15, cc = c & 31, ob = rr * 64 + cc * 2; return st * 1024 + (ob ^ (((ob >> 9) & 1) << 5)); }
__host__ __device__ __forceinline__ void stage_rc(int b, int& R, int& C) { const int st = b / 1024, sb = b % 1024, swz = sb ^ (((sb >> 9) & 1) << 5); R = (st >> 1) * 16 + swz / 64; C = (st & 1) * 32 + (swz % 64) / 2; }
__host__ __device__ __forceinline__ int perm32(int rho) { const int n = rho >> 4, i = rho & 15; return 8 * (i >> 2) + 4 * n + (i & 3); }

struct Unit { int pm, pn; };
struct Gemm { const bf16_t* A; const bf16_t* Bt; int M, N, K; };

struct StaticOrder {
    int nM, nN, nwg, G, c;
    __host__ __device__ void init(int M, int N, int G_, int c_) { nM = M / BM; nN = N / BM; nwg = nM * nN; G = G_; c = c_; }
    __host__ __device__ bool next(int i, Unit& u) const {
        const long L = (long)i * G + c; if (L >= nwg) return false;
        int wgid = (int)L; { const int q = nwg / NXCD, r = nwg % NXCD, xcd = wgid % NXCD, off = wgid / NXCD; wgid = (xcd < r ? xcd * (q + 1) : r * (q + 1) + (xcd - r) * q) + off; }
        const int nig = WGM * nN, gid = wgid / nig, fm = gid * WGM, gsz = (nM - fm) < WGM ? (nM - fm) : WGM;
        u.pm = fm + ((wgid % nig) % gsz); u.pn = (wgid % nig) / gsz; return true;
    }
    __device__ __forceinline__ void a_ready(const Unit&) const {}
    __device__ __forceinline__ void done(const Unit&) const {}
};


__device__ __forceinline__ unsigned cvt_pk_bf16(float lo, float hi) { unsigned r; asm volatile("v_cvt_pk_bf16_f32 %0, %1, %2" : "=v"(r) : "v"(lo), "v"(hi)); return r; }
struct EpiOut {
    static constexpr bool PERM = true, AFTER_DRAIN = false;
    bf16_t* O; int ldc; int act;
    const float* ct; const float* st; int rope_lo, rope_hi, rope_k, seq;
    __device__ __forceinline__ void operator()(const f32x4 (&acc)[2][2][4][2], const Unit& u, int wr, int wc, int fr, int fq) const {
        const int row0 = u.pm * BM + wr * 64 + fr; const int col0 = u.pn * BM + wc * 32 + 8 * fq;
#pragma unroll
        for (int ai = 0; ai < 2; ++ai)
#pragma unroll
            for (int m = 0; m < 4; ++m) { const int row = row0 + ai * HALF + m * 16; bf16_t* rowp = O + (size_t)row * ldc + col0;
#pragma unroll
                for (int bj = 0; bj < 2; ++bj) { f32x4 v0 = acc[ai][bj][m][0], v1 = acc[ai][bj][m][1];
                    if (act == 1) {
#pragma unroll
                        for (int e = 0; e < 4; ++e) { float a = fmaxf(v0[e], 0.f), b = fmaxf(v1[e], 0.f); v0[e] = a * a; v1[e] = b * b; } }
                    if (act == 2) { const int cb = u.pn * BM + wc * 32 + bj * HALF;
                        if (cb >= rope_lo && cb < rope_hi) { const int pos = row % seq, g = ((col0 + bj * HALF) & 63) >> 3;
                            const f32x4 c = *(const f32x4*)(ct + pos * 32 + 4 * g), sn = *(const f32x4*)(st + pos * 32 + 4 * g); const float sc = cb >= rope_k ? 0.125f : 1.f;
                            const f32x4 x1 = v0, x2 = v1; v0 = (x1 * c - x2 * sn) * sc; v1 = (x2 * c + x1 * sn) * sc; } }
                    u32x4 w; w.x = cvt_pk_bf16(v0[0], v0[1]); w.y = cvt_pk_bf16(v0[2], v0[3]); w.z = cvt_pk_bf16(v1[0], v1[1]); w.w = cvt_pk_bf16(v1[2], v1[3]);
                    *(u32x4*)(rowp + bj * HALF) = w; } }
    }
};

template <class Epi, class Sched, bool ALIGN_EPI = false, bool SP2 = false>
__device__ __forceinline__ void gemm_phase(PG8_LAS unsigned char* lds, const Gemm g, const Sched& S, const Epi& E) {
    const int tid = threadIdx.x, wid = __builtin_amdgcn_readfirstlane(tid >> 6), lane = tid & 63, wr = wid >> 2, wc = wid & 3, fr = lane & 15, fq = lane >> 4;
    const int K = g.K, nt = K / BK;
    unsigned voffA[2], voffB[2];
#pragma unroll
    for (int i = 0; i < 2; ++i) { int R, C; stage_rc(tid * 16 + i * 8192, R, C); const int Rb = Epi::PERM ? ((R & ~31) + perm32(R & 31)) : R;
        voffA[i] = (unsigned)(R * K + C) * 2u; voffB[i] = (unsigned)(Rb * K + C) * 2u; }
    const size_t kstep = (size_t)(BK * 2);
    const size_t hstep = (size_t)HALF * K * 2;
    const size_t tstep = 2 * hstep;
    const unsigned ldsw = (unsigned)wid * 1024u;
    const int aoff = lds_byte(wr * 64 + fr, fq * 8), boff = lds_byte(wc * 32 + fr, fq * 8);
#define PG8_SA(b, h) (((b) * 2 + (h)) * HTB)
#define PG8_SB(b, h) ((4 + (b) * 2 + (h)) * HTB)
#define PG8_STAGE(bufoff, gbase, voff) do { _Pragma("unroll") for (int _i = 0; _i < 2; ++_i) \
        __builtin_amdgcn_global_load_lds((const unsigned*)((const char*)(gbase) + (voff)[_i]), (PG8_LAS unsigned*)(lds + (bufoff) + ldsw + _i * 8192), 16, 0, 0); } while (0)
#define PG8_LDA(dst, b, h) do { _Pragma("unroll") for (int m = 0; m < 4; ++m) _Pragma("unroll") for (int k = 0; k < 2; ++k) dst[m][k] = *(const PG8_LAS bf16x8*)(lds + PG8_SA(b, h) + aoff + m * 2048 + k * 1024); } while (0)
#define PG8_LDB(dst, b, h) do { _Pragma("unroll") for (int n = 0; n < 2; ++n) _Pragma("unroll") for (int k = 0; k < 2; ++k) dst[n][k] = *(const PG8_LAS bf16x8*)(lds + PG8_SB(b, h) + boff + n * 2048 + k * 1024); } while (0)
#define PG8_MMA(ai, bj, At, Bt) do { __builtin_amdgcn_s_setprio(1); _Pragma("unroll") for (int m = 0; m < 4; ++m) _Pragma("unroll") for (int n = 0; n < 2; ++n) _Pragma("unroll") for (int k = 0; k < 2; ++k) \
        acc[ai][bj][m][n] = __builtin_amdgcn_mfma_f32_16x16x32_bf16(Bt[n][k], At[m][k], acc[ai][bj][m][n], 0, 0, 0); __builtin_amdgcn_s_setprio(0); } while (0)
#define PG8_WAIT_V(n) asm volatile("s_waitcnt vmcnt(" #n ")" ::: "memory")
#define PG8_WAIT_L(n) asm volatile("s_waitcnt lgkmcnt(" #n ")" ::: "memory")
#define PG8_BAR __builtin_amdgcn_s_barrier()
#define PG8_SCHED __builtin_amdgcn_sched_barrier(0)
    Unit cur, nxt; int ui = 0;
    if (!S.next(0, cur)) return;
    f32x4 acc[2][2][4][2];
#pragma unroll
    for (int a = 0; a < 2; ++a)
#pragma unroll
        for (int b = 0; b < 2; ++b)
#pragma unroll
            for (int m = 0; m < 4; ++m)
#pragma unroll
                for (int n = 0; n < 2; ++n) acc[a][b][m][n] = (f32x4){0.f, 0.f, 0.f, 0.f};
    bf16x8 At[4][2], B0[2][2], B1[2][2];
    const char* cA = (const char*)g.A + (size_t)cur.pm * tstep; const char* cB = (const char*)g.Bt + (size_t)cur.pn * tstep;
    S.a_ready(cur);
    if constexpr (SP2) {
        PG8_STAGE(PG8_SB(0, 0), cB, voffB); PG8_STAGE(PG8_SB(0, 1), cB + hstep, voffB); PG8_STAGE(PG8_SA(0, 0), cA, voffA); PG8_STAGE(PG8_SA(0, 1), cA + hstep, voffA);
        if (wr == 1) PG8_BAR;
        PG8_WAIT_V(2); PG8_BAR;
        PG8_STAGE(PG8_SB(1, 0), cB + kstep, voffB); PG8_STAGE(PG8_SA(1, 0), cA + kstep, voffA); PG8_STAGE(PG8_SB(1, 1), cB + hstep + kstep, voffB);
        PG8_WAIT_V(6); PG8_BAR;
    } else {
        PG8_STAGE(PG8_SB(0, 0), cB, voffB); PG8_STAGE(PG8_SA(0, 0), cA, voffA); PG8_STAGE(PG8_SB(0, 1), cB + hstep, voffB); PG8_STAGE(PG8_SA(0, 1), cA + hstep, voffA);
        if (wr == 1) PG8_BAR;
        PG8_WAIT_V(4); PG8_BAR;
        PG8_STAGE(PG8_SB(1, 0), cB + kstep, voffB); PG8_STAGE(PG8_SA(1, 0), cA + kstep, voffA); PG8_STAGE(PG8_SB(1, 1), cB + hstep + kstep, voffB);
        PG8_WAIT_V(6); PG8_BAR;
    }
    for (;;) {
        const bool has_next = S.next(ui + 1, nxt);
        const char* nA = has_next ? (const char*)g.A + (size_t)nxt.pm * tstep : cA; const char* nB = has_next ? (const char*)g.Bt + (size_t)nxt.pn * tstep : cB;
        for (int t = 0; t < nt; t += 2) {
            const bool last = (t == nt - 2);
            const char* a1 = cA + (size_t)(t + 1) * kstep;
            const char* a2 = last ? nA : cA + (size_t)(t + 2) * kstep; const char* b2 = last ? nB : cB + (size_t)(t + 2) * kstep;
            const char* a3 = a2 + kstep; const char* b3 = b2 + kstep;
            if (last && has_next) S.a_ready(nxt);
            if constexpr (SP2) {
            PG8_LDB(B0, 0, 0); PG8_LDB(B1, 0, 1); PG8_SCHED; PG8_LDA(At, 0, 0); PG8_STAGE(PG8_SA(1, 1), a1 + hstep, voffA);
            PG8_WAIT_V(8); PG8_WAIT_L(0); PG8_BAR; PG8_MMA(0, 0, At, B0); PG8_MMA(0, 1, At, B1); PG8_BAR; PG8_SCHED;
            PG8_LDA(At, 0, 1); PG8_STAGE(PG8_SB(0, 0), b2, voffB); PG8_STAGE(PG8_SB(0, 1), b2 + hstep, voffB); PG8_STAGE(PG8_SA(0, 0), a2, voffA);
            PG8_WAIT_V(8); PG8_WAIT_L(0); PG8_BAR; PG8_MMA(1, 0, At, B0); PG8_MMA(1, 1, At, B1); PG8_BAR; PG8_SCHED;
            PG8_LDB(B0, 1, 0); PG8_LDB(B1, 1, 1); PG8_SCHED; PG8_LDA(At, 1, 0); PG8_STAGE(PG8_SA(0, 1), a2 + hstep, voffA);
            PG8_WAIT_V(8); PG8_WAIT_L(0); PG8_BAR; PG8_MMA(0, 0, At, B0); PG8_MMA(0, 1, At, B1); PG8_BAR; PG8_SCHED;
            PG8_LDA(At, 1, 1); PG8_STAGE(PG8_SB(1, 0), b3, voffB); PG8_STAGE(PG8_SB(1, 1), b3 + hstep, voffB); PG8_STAGE(PG8_SA(1, 0), a3, voffA);
            PG8_WAIT_V(8); PG8_WAIT_L(0); PG8_BAR; PG8_MMA(1, 0, At, B0); PG8_MMA(1, 1, At, B1); PG8_BAR; PG8_SCHED;
            } else {
            PG8_LDB(B0, 0, 0); PG8_SCHED; PG8_LDA(At, 0, 0); PG8_STAGE(PG8_SA(1, 1), a1 + hstep, voffA);
            PG8_WAIT_L(8); PG8_BAR; PG8_WAIT_L(0); PG8_MMA(0, 0, At, B0); PG8_BAR; PG8_SCHED;
            PG8_LDB(B1, 0, 1); PG8_STAGE(PG8_SB(0, 0), b2, voffB);
            PG8_BAR; PG8_WAIT_L(0); PG8_MMA(0, 1, At, B1); PG8_BAR;
            PG8_LDA(At, 0, 1); PG8_STAGE(PG8_SA(0, 0), a2, voffA);
            PG8_BAR; PG8_WAIT_L(0); PG8_MMA(1, 0, At, B0); PG8_BAR; PG8_SCHED;
            PG8_STAGE(PG8_SB(0, 1), b2 + hstep, voffB);
            PG8_WAIT_V(6); PG8_BAR; PG8_MMA(1, 1, At, B1); PG8_BAR;
            PG8_LDB(B0, 1, 0); PG8_SCHED; PG8_LDA(At, 1, 0); PG8_STAGE(PG8_SA(0, 1), a2 + hstep, voffA);
            PG8_WAIT_L(8); PG8_BAR; PG8_WAIT_L(0); PG8_MMA(0, 0, At, B0); PG8_BAR; PG8_SCHED;
            PG8_LDB(B1, 1, 1); PG8_STAGE(PG8_SB(1, 0), b3, voffB);
            PG8_BAR; PG8_WAIT_L(0); PG8_MMA(0, 1, At, B1); PG8_BAR;
            PG8_LDA(At, 1, 1); PG8_STAGE(PG8_SA(1, 0), a3, voffA);
            PG8_BAR; PG8_WAIT_L(0); PG8_MMA(1, 0, At, B0); PG8_BAR; PG8_SCHED;
            PG8_STAGE(PG8_SB(1, 1), b3 + hstep, voffB);
            PG8_WAIT_V(6); PG8_BAR; PG8_MMA(1, 1, At, B1); PG8_BAR;
            }
        }
        if constexpr (ALIGN_EPI) { if (wr == 0) PG8_BAR; }
        if constexpr (!Epi::AFTER_DRAIN) { E(acc, cur, wr, wc, fr, fq); S.done(cur); }
        if (!has_next) break;
#pragma unroll
        for (int a = 0; a < 2; ++a)
#pragma unroll
            for (int b = 0; b < 2; ++b)
#pragma unroll
                for (int m = 0; m < 4; ++m)
#pragma unroll
                    for (int n = 0; n < 2; ++n) acc[a][b][m][n] = (f32x4){0.f, 0.f, 0.f, 0.f};
        cur = nxt; cA = nA; cB = nB; ++ui;
        if constexpr (ALIGN_EPI) { if (wr == 1) PG8_BAR; }
    }
    PG8_WAIT_V(0);
    if constexpr (!ALIGN_EPI) { if (wr == 0) PG8_BAR; }
    PG8_BAR;
    if constexpr (Epi::AFTER_DRAIN) { E.fused(acc, cur, wr, wc, fr, fq, lds, wid, lane); S.done(cur); }
#undef PG8_SA
#undef PG8_SB
#undef PG8_STAGE
#undef PG8_LDA
#undef PG8_LDB
#undef PG8_MMA
#undef PG8_WAIT_V
#undef PG8_WAIT_L
#undef PG8_BAR
#undef PG8_SCHED
}
}

#define LAS __attribute__((address_space(3)))
typedef unsigned short bf16;
typedef short bf16x8 __attribute__((ext_vector_type(8)));
typedef float f32x4 __attribute__((ext_vector_type(4)));
typedef unsigned u32x4 __attribute__((ext_vector_type(4)));
typedef unsigned u32x2 __attribute__((ext_vector_type(2)));
constexpr int NWAVES = 8, NT = 512;
constexpr int BATCH = 4, SEQ = 8192, DM = 1024, M = BATCH * SEQ, DEPTH = 2;
constexpr int NC = SEQ / 64, AH = 6, RH = 6, CW = 256, CK = 31;
constexpr int DIN = 3200, DINP = 3328, DFF = 4096;
constexpr int U_AQ = 0, U_AK = 384, U_AV = 768, U_CA = 1152, U_CG = 1408, U_RQ = 1664, U_RK = 2048, U_RV = 2432, U_RG = 2816;
constexpr int Y_ATT = 0, Y_CONV = 384, Y_RET = 640;
constexpr float EPS = 1e-6f, LOG2E = 1.4426950408889634f;
constexpr size_t MiB = 1u << 20;
constexpr size_t WS_ROPE = 1 * MiB;
constexpr size_t WS_WIN = 4 * MiB;
constexpr size_t WS_WOUT = 17 * MiB;
constexpr size_t WS_WUP = 21 * MiB;
constexpr size_t WS_WDN = 37 * MiB;
constexpr size_t WS_H = 54 * MiB;
constexpr size_t WS_MIX = 118 * MiB;
constexpr size_t WS_KV = 118 * MiB;
constexpr size_t WS_ST = 182 * MiB;
constexpr size_t WS_U = 240 * MiB;
constexpr size_t WS_YMIX = 448 * MiB;
constexpr size_t WS_F1 = 240 * MiB;
constexpr size_t WS_END = 512 * MiB;
constexpr int LDS_BYTES = 147456;

__device__ __forceinline__ float bflo(unsigned w) { return __uint_as_float(w << 16); }
__device__ __forceinline__ float bfhi(unsigned w) { return __uint_as_float(w & 0xffff0000u); }
__device__ __forceinline__ unsigned pk2(float lo, float hi) { return pg8::cvt_pk_bf16(lo, hi); }
__device__ __forceinline__ float wave_sum(float v) {
#pragma unroll
    for (int o = 1; o < 64; o <<= 1) v += __shfl_xor(v, o);
    return v;
}
__device__ __forceinline__ float fexp2(float x) { return __builtin_amdgcn_exp2f(x); }
__device__ __forceinline__ float sigmoidf_(float x) { return __builtin_amdgcn_rcpf(1.f + fexp2(-x * LOG2E)); }
#define LDS_BARRIER() do { asm volatile("s_waitcnt lgkmcnt(0)" ::: "memory"); __builtin_amdgcn_s_barrier(); asm volatile("" ::: "memory"); } while (0)
#define MFMA16(a, b, c) __builtin_amdgcn_mfma_f32_16x16x32_bf16((a), (b), (c), 0, 0, 0)

struct Args {
    const float* x; const float* g_mix_pre; const float* g_mix_post; const float* g_mlp_pre; const float* g_mlp_post;
    const float* w_in; const float* rel_bias; const float* conv_w; const float* conv_b; const float* conv_ln_g; const float* conv_ln_b;
    const float* w_out; const float* w_up; const float* w_down;
    float* out; unsigned char* ws;
    int ph_lo, ph_hi;
};

template <bool ROPEPERM> __device__ __forceinline__ void transpose_item(const float* W, int K, int N, bf16* WT, LAS float* scr, int item, int lane) {
    const int nblk = N / 32, kb = item / nblk, nb = item % nblk, k0 = 64 * kb, n0 = 32 * nb;
#pragma unroll 8
    for (int i = 0; i < 32; ++i) { const int kk = 2 * i + (lane >> 5); scr[kk * 33 + (lane & 31)] = W[(size_t)(k0 + kk) * N + n0 + (lane & 31)]; }
    asm volatile("s_waitcnt lgkmcnt(0)" ::: "memory");
    const int c = lane & 7;
#pragma unroll
    for (int j = 0; j < 4; ++j) { const int n = (lane >> 3) + 8 * j; const LAS float* s = scr + (8 * c) * 33 + n;
        u32x4 o; o.x = pk2(s[0 * 33], s[1 * 33]); o.y = pk2(s[2 * 33], s[3 * 33]); o.z = pk2(s[4 * 33], s[5 * 33]); o.w = pk2(s[6 * 33], s[7 * 33]);
        int nr = n0 + n; if (ROPEPERM && nr >= U_RQ && nr < U_RV) { const int d = nr & 63; nr = (nr & ~63) + (d < 32 ? 8 * (d >> 2) + (d & 3) : 8 * ((d - 32) >> 2) + 4 + (d & 3)); }
        *(u32x4*)(WT + (size_t)nr * K + k0 + 8 * c) = o; }
    asm volatile("s_waitcnt lgkmcnt(0)" ::: "memory");
}
__device__ __forceinline__ void rms_row_to_bf16(const float* xrow, const float* g, bf16* orow, int lane) {
    const f32x4* xr = (const f32x4*)xrow + lane; const f32x4* gr = (const f32x4*)g + lane;
    f32x4 v[4]; float s = 0.f;
#pragma unroll
    for (int j = 0; j < 4; ++j) { v[j] = xr[64 * j]; s += (v[j].x * v[j].x + v[j].y * v[j].y) + (v[j].z * v[j].z + v[j].w * v[j].w); }
    const float r = rsqrtf(wave_sum(s) * (1.f / DM) + EPS);
    u32x2* o8 = (u32x2*)orow + lane;
#pragma unroll
    for (int j = 0; j < 4; ++j) { const f32x4 gg = gr[64 * j]; u32x2 w; w.x = pk2(v[j].x * r * gg.x, v[j].y * r * gg.y); w.y = pk2(v[j].z * r * gg.z, v[j].w * r * gg.w); o8[64 * j] = w; }
}
__device__ __forceinline__ void prologue(const Args& a, LAS unsigned char* lds, int gw, int NGW, int wave, int lane) {
    unsigned char* ws = a.ws;
    LAS float* scr = (LAS float*)(lds + wave * 16384);
    constexpr int I_IN = (DM / 64) * (DIN / 32), I_OUT = (DM / 64) * (DM / 32), I_UP = (DM / 64) * (DFF / 32), I_DN = (DFF / 64) * (DM / 32);
    constexpr int PER_L = I_IN + I_OUT + I_UP + I_DN;
    for (int it = gw; it < DEPTH * PER_L; it += NGW) {
        const int l = it / PER_L; int r = it % PER_L;
        if (r < I_IN) { transpose_item<true>(a.w_in + (size_t)l * DM * DIN, DM, DIN, (bf16*)(ws + WS_WIN) + (size_t)l * DINP * DM, scr, r, lane); continue; } r -= I_IN;
        if (r < I_OUT) { transpose_item<false>(a.w_out + (size_t)l * DM * DM, DM, DM, (bf16*)(ws + WS_WOUT) + (size_t)l * DM * DM, scr, r, lane); continue; } r -= I_OUT;
        if (r < I_UP) { transpose_item<false>(a.w_up + (size_t)l * DM * DFF, DM, DFF, (bf16*)(ws + WS_WUP) + (size_t)l * DFF * DM, scr, r, lane); continue; } r -= I_UP;
        transpose_item<false>(a.w_down + (size_t)l * DFF * DM, DFF, DM, (bf16*)(ws + WS_WDN) + (size_t)l * DM * DFF, scr, r, lane);
    }
    for (int i = gw * 64 + lane; i < DEPTH * 16384; i += NGW * 64) { const int l = i / 16384, r = i % 16384;
        ((u32x4*)((bf16*)(ws + WS_WIN) + ((size_t)l * DINP + DIN) * DM))[r] = (u32x4){0u, 0u, 0u, 0u}; }
    float* ct = (float*)(ws + WS_ROPE); float* st = ct + SEQ * 32;
    for (int i = gw * 64 + lane; i < SEQ * 32; i += NGW * 64) { const int s = i >> 5, k = i & 31;
        const float lin = (k == 31) ? 1.0f : (float)k * (1.0f / 31.0f); const float invf = 1.0f / exp2f(lin * 13.287712379549449f); const float ang = (float)s * invf; double t = (double)ang * 0.15915494309189535; t -= rint(t); const float tf = (float)t;
        ct[i] = __builtin_amdgcn_cosf(tf); st[i] = __builtin_amdgcn_sinf(tf); }
    for (int m = gw; m < M; m += NGW) rms_row_to_bf16(a.x + (size_t)m * DM, a.g_mix_pre, (bf16*)(ws + WS_H) + (size_t)m * DM, lane);
}

__device__ __forceinline__ void ephase(const float* xold, const bf16* y, const float* ga, const float* gb, float* xout, bf16* hout, int gw, int NGW, int lane) {
    for (int m = gw; m < M; m += NGW) {
        const f32x4* xr = (const f32x4*)(xold + (size_t)m * DM) + lane; const u32x2* yr = (const u32x2*)(y + (size_t)m * DM) + lane;
        f32x4 xv[4], yv[4]; float s = 0.f;
#pragma unroll
        for (int j = 0; j < 4; ++j) { xv[j] = xr[64 * j]; const u32x2 w = yr[64 * j]; yv[j] = (f32x4){bflo(w.x), bfhi(w.x), bflo(w.y), bfhi(w.y)};
            s += (yv[j].x * yv[j].x + yv[j].y * yv[j].y) + (yv[j].z * yv[j].z + yv[j].w * yv[j].w); }
        const float r1 = rsqrtf(wave_sum(s) * (1.f / DM) + EPS); float s2 = 0.f;
        f32x4* xo = (f32x4*)(xout + (size_t)m * DM) + lane;
#pragma unroll
        for (int j = 0; j < 4; ++j) { const f32x4 gg = ((const f32x4*)ga)[lane + 64 * j]; xv[j] = xv[j] + yv[j] * r1 * gg; xo[64 * j] = xv[j];
            s2 += (xv[j].x * xv[j].x + xv[j].y * xv[j].y) + (xv[j].z * xv[j].z + xv[j].w * xv[j].w); }
        if (gb) { const float r2 = rsqrtf(wave_sum(s2) * (1.f / DM) + EPS); u32x2* ho = (u32x2*)(hout + (size_t)m * DM) + lane;
#pragma unroll
            for (int j = 0; j < 4; ++j) { const f32x4 gg = ((const f32x4*)gb)[lane + 64 * j]; u32x2 w; w.x = pk2(xv[j].x * r2 * gg.x, xv[j].y * r2 * gg.y); w.y = pk2(xv[j].z * r2 * gg.z, xv[j].w * r2 * gg.w); ho[64 * j] = w; } }
    }
}

constexpr int VTS = 72;
__device__ __forceinline__ void scatter8(LAS bf16* T, int row0, int col, u32x4 v) {
    T[(row0 + 0) * VTS + col] = (bf16)(v.x & 0xffffu); T[(row0 + 1) * VTS + col] = (bf16)(v.x >> 16);
    T[(row0 + 2) * VTS + col] = (bf16)(v.y & 0xffffu); T[(row0 + 3) * VTS + col] = (bf16)(v.y >> 16);
    T[(row0 + 4) * VTS + col] = (bf16)(v.z & 0xffffu); T[(row0 + 5) * VTS + col] = (bf16)(v.z >> 16);
    T[(row0 + 6) * VTS + col] = (bf16)(v.w & 0xffffu); T[(row0 + 7) * VTS + col] = (bf16)(v.w >> 16);
}
__device__ __forceinline__ bf16x8 ld_tr_pair(const LAS bf16* T, int row, int col_lo, int col_hi) {
    const u32x2 lo = *(const LAS u32x2*)(T + row * VTS + col_lo), hi = *(const LAS u32x2*)(T + row * VTS + col_hi);
    const u32x4 w = (u32x4){lo.x, lo.y, hi.x, hi.y}; return __builtin_bit_cast(bf16x8, w);
}
__device__ __forceinline__ bf16x8 pack_p(const f32x4 a, const f32x4 b) {
    const u32x4 w = (u32x4){pk2(a[0], a[1]), pk2(a[2], a[3]), pk2(b[0], b[1]), pk2(b[2], b[3])}; return __builtin_bit_cast(bf16x8, w);
}
constexpr int KLS = 136;
__device__ __forceinline__ void attn_unit(LAS unsigned char* lds, const bf16* u, const float* relb, bf16* ymix, int b, int n, int hp, int tid, int wid, int lane) {
    const int fr = lane & 15, fq = lane >> 4;
    LAS bf16* Vt0 = (LAS bf16*)lds;
    LAS bf16* Kl0 = (LAS bf16*)(lds + 2 * 128 * VTS * 2);
    LAS float* bl = (LAS float*)(lds + 2 * 128 * VTS * 2 + 2 * 64 * KLS * 2);
    const int hl = wid >> 2, qg = wid & 3, head = 2 * hp + hl;
    const size_t tok_q = (size_t)b * SEQ + n * 64 + qg * 16 + fr;
    const int c0 = n >= 8 ? 0 : 8 - n;
    const int kkey = tid >> 3, kd0 = (tid & 7) * 16;
    const size_t ktok0 = (size_t)b * SEQ + (size_t)(n + c0 - 8) * 64;
    const bf16* vsrc = u + (ktok0 + lane) * DINP + U_AV + (2 * hp) * 64 + 16 * wid;
    const bf16* ksrc = u + (ktok0 + kkey) * DINP + U_AK + (2 * hp) * 64 + kd0;
    u32x4 v0 = *(const u32x4*)vsrc, v1 = *(const u32x4*)(vsrc + 8);
    u32x4 k0 = *(const u32x4*)ksrc, k1 = *(const u32x4*)(ksrc + 8);
    u32x4 v0n = v0, v1n = v1, k0n = k0, k1n = k1;
    if (c0 < 8) { vsrc += (size_t)64 * DINP; ksrc += (size_t)64 * DINP;
        v0n = *(const u32x4*)vsrc; v1n = *(const u32x4*)(vsrc + 8); k0n = *(const u32x4*)ksrc; k1n = *(const u32x4*)(ksrc + 8); }
    bf16x8 Qb[2];
#pragma unroll
    for (int ks = 0; ks < 2; ++ks) Qb[ks] = *(const bf16x8*)(u + tok_q * DINP + U_AQ + head * 64 + ks * 32 + 8 * fq);
    LDS_BARRIER();
    for (int i = tid; i < 2 * 257; i += NT) { const int h2 = i / 257, k = i % 257; bl[h2 * 260 + k] = relb[(2 * hp + h2) * 257 + k] * LOG2E; }
    float m_run = -1e30f, l_run = 0.f; f32x4 O[4];
#pragma unroll
    for (int dt = 0; dt < 4; ++dt) O[dt] = (f32x4){0.f, 0.f, 0.f, 0.f};
    for (int c = c0; c <= 8; ++c) {
        LAS bf16* Vt = Vt0 + (c & 1) * 128 * VTS; LAS bf16* Kl = Kl0 + (c & 1) * 64 * KLS;
        *(LAS u32x4*)(Kl + kkey * KLS + kd0) = k0; *(LAS u32x4*)(Kl + kkey * KLS + kd0 + 8) = k1;
        scatter8(Vt, 16 * wid, lane, v0); scatter8(Vt, 16 * wid + 8, lane, v1);
        v0 = v0n; v1 = v1n; k0 = k0n; k1 = k1n;
        if (c < 7) { vsrc += (size_t)64 * DINP; ksrc += (size_t)64 * DINP;
            v0n = *(const u32x4*)vsrc; v1n = *(const u32x4*)(vsrc + 8); k0n = *(const u32x4*)ksrc; k1n = *(const u32x4*)(ksrc + 8); }
        LDS_BARRIER();
        f32x4 st[4];
#pragma unroll
        for (int kt = 0; kt < 4; ++kt) { st[kt] = (f32x4){0.f, 0.f, 0.f, 0.f};
#pragma unroll
            for (int ks = 0; ks < 2; ++ks) { const bf16x8 Ka = *(const LAS bf16x8*)(Kl + (kt * 16 + fr) * KLS + hl * 64 + ks * 32 + 8 * fq); st[kt] = MFMA16(Ka, Qb[ks], st[kt]); } }
        float mx = -1e30f;
        if (c >= 6) { const int relbase = (qg * 16 + fr) + 64 * (8 - c);
#pragma unroll
            for (int kt = 0; kt < 4; ++kt)
#pragma unroll
                for (int r = 0; r < 4; ++r) { const int rel = relbase - (kt * 16 + 4 * fq + r); const int idx = (rel < 128 ? rel : 128) + 128;
                    const float sv = st[kt][r] * (0.125f * LOG2E) + bl[hl * 260 + idx]; st[kt][r] = sv; mx = fmaxf(mx, sv); }
        } else { const float bc = bl[hl * 260 + 256];
#pragma unroll
            for (int kt = 0; kt < 4; ++kt)
#pragma unroll
                for (int r = 0; r < 4; ++r) { const float sv = st[kt][r] * (0.125f * LOG2E) + bc; st[kt][r] = sv; mx = fmaxf(mx, sv); } }
        if (__builtin_amdgcn_ballot_w64(mx > m_run + 8.f) != 0ull) {
            mx = fmaxf(mx, __shfl_xor(mx, 16)); mx = fmaxf(mx, __shfl_xor(mx, 32));
            const float m_new = fmaxf(m_run, mx), alpha = fexp2(m_run - m_new);
            l_run *= alpha; m_run = m_new;
#pragma unroll
            for (int dt = 0; dt < 4; ++dt) O[dt] = O[dt] * alpha;
        }
        float psum = 0.f;
#pragma unroll
        for (int kt = 0; kt < 4; ++kt)
#pragma unroll
            for (int r = 0; r < 4; ++r) { const float p = fexp2(st[kt][r] - m_run); st[kt][r] = p; psum += p; }
        l_run += psum;
#pragma unroll
        for (int kk = 0; kk < 2; ++kk) { const bf16x8 pb = pack_p(st[2 * kk], st[2 * kk + 1]);
#pragma unroll
            for (int dt = 0; dt < 4; ++dt) { const bf16x8 Va = ld_tr_pair(Vt, hl * 64 + dt * 16 + fr, 32 * kk + 4 * fq, 32 * kk + 16 + 4 * fq); O[dt] = MFMA16(Va, pb, O[dt]); } }
    }
    l_run += __shfl_xor(l_run, 16); l_run += __shfl_xor(l_run, 32);
    const float inv = 1.f / l_run;
#pragma unroll
    for (int dt = 0; dt < 4; ++dt) { u32x2 w; w.x = pk2(O[dt][0] * inv, O[dt][1] * inv); w.y = pk2(O[dt][2] * inv, O[dt][3] * inv);
        *(u32x2*)(ymix + tok_q * DM + Y_ATT + head * 64 + dt * 16 + 4 * fq) = w; }
}

__device__ __forceinline__ void conv_unit(LAS unsigned char* lds, const bf16* u, const float* cw, const float* cb, const float* lng, const float* lnb, bf16* ymix, int b, int n, int tid, int wid, int lane) {
    LAS float* yb = (LAS float*)lds;
    __syncthreads();
    for (int i = tid; i < 94 * 32; i += NT) { const int tt = i >> 5, cgp = i & 31; const int t = n * 64 - 30 + tt;
        f32x4 o0 = (f32x4){0.f, 0.f, 0.f, 0.f}, o1 = o0;
        if (t >= 0) { const bf16* src = u + ((size_t)b * SEQ + t) * DINP + U_CA + cgp * 8; const u32x4 av = *(const u32x4*)src, gv = *(const u32x4*)(src + CW);
            o0 = (f32x4){bflo(av.x) * sigmoidf_(bflo(gv.x)), bfhi(av.x) * sigmoidf_(bfhi(gv.x)), bflo(av.y) * sigmoidf_(bflo(gv.y)), bfhi(av.y) * sigmoidf_(bfhi(gv.y))};
            o1 = (f32x4){bflo(av.z) * sigmoidf_(bflo(gv.z)), bfhi(av.z) * sigmoidf_(bfhi(gv.z)), bflo(av.w) * sigmoidf_(bflo(gv.w)), bfhi(av.w) * sigmoidf_(bfhi(gv.w))}; }
        *(LAS f32x4*)(yb + tt * 256 + cgp * 8) = o0; *(LAS f32x4*)(yb + tt * 256 + cgp * 8 + 4) = o1; }
    __syncthreads();
    const int ch = tid & 255, half = tid >> 8;
    float w[CK];
#pragma unroll
    for (int j = 0; j < CK; ++j) w[j] = cw[j * CW + ch];
    float acc[32]; const float bias = cb[ch];
    { float yv[62];
#pragma unroll
      for (int r = 0; r < 62; ++r) yv[r] = yb[(half * 32 + r) * 256 + ch];
#pragma unroll
      for (int i = 0; i < 32; ++i) { float sacc = bias;
#pragma unroll
          for (int j = 0; j < CK; ++j) sacc += w[j] * yv[i + j];
          acc[i] = sacc; } }
    __syncthreads();
#pragma unroll
    for (int i = 0; i < 32; ++i) yb[(half * 32 + i) * 256 + ch] = acc[i];
    __syncthreads();
    const f32x4 gg = ((const f32x4*)lng)[lane], bb = ((const f32x4*)lnb)[lane];
    f32x4 v[8]; float sm[8], sq[8];
#pragma unroll
    for (int k = 0; k < 8; ++k) { v[k] = *(const LAS f32x4*)(yb + (wid * 8 + k) * 256 + 4 * lane); sm[k] = (v[k].x + v[k].y) + (v[k].z + v[k].w); }
#pragma unroll
    for (int o = 1; o < 64; o <<= 1)
#pragma unroll
        for (int k = 0; k < 8; ++k) sm[k] += __shfl_xor(sm[k], o);
#pragma unroll
    for (int k = 0; k < 8; ++k) { v[k] = v[k] - sm[k] * (1.f / 256.f); sq[k] = (v[k].x * v[k].x + v[k].y * v[k].y) + (v[k].z * v[k].z + v[k].w * v[k].w); }
#pragma unroll
    for (int o = 1; o < 64; o <<= 1)
#pragma unroll
        for (int k = 0; k < 8; ++k) sq[k] += __shfl_xor(sq[k], o);
#pragma unroll
    for (int k = 0; k < 8; ++k) { const int t = wid * 8 + k; const float rstd = rsqrtf(sq[k] * (1.f / 256.f) + EPS);
        f32x4 y = v[k] * rstd * gg + bb; y = (f32x4){y.x * sigmoidf_(y.x), y.y * sigmoidf_(y.y), y.z * sigmoidf_(y.z), y.w * sigmoidf_(y.w)};
        u32x2 o; o.x = pk2(y.x, y.y); o.y = pk2(y.z, y.w);
        *(u32x2*)(ymix + ((size_t)b * SEQ + n * 64 + t) * DM + Y_CONV + 4 * lane) = o; }
}

__device__ __forceinline__ float ret_logg2(int h) { return log2f(1.f - exp2f(-5.f - (float)h)); }
__device__ __forceinline__ void rope8(const u32x4 a, const u32x4 c, const float* ct, const float* st, int pos, int dg, float scale, float (&o1)[8], float (&o2)[8]) {
    const f32x4 c0 = *(const f32x4*)(ct + pos * 32 + dg * 8), c1 = *(const f32x4*)(ct + pos * 32 + dg * 8 + 4);
    const f32x4 s0 = *(const f32x4*)(st + pos * 32 + dg * 8), s1 = *(const f32x4*)(st + pos * 32 + dg * 8 + 4);
    const float x1[8] = {bflo(a.x), bfhi(a.x), bflo(a.y), bfhi(a.y), bflo(a.z), bfhi(a.z), bflo(a.w), bfhi(a.w)};
    const float x2[8] = {bflo(c.x), bfhi(c.x), bflo(c.y), bfhi(c.y), bflo(c.z), bfhi(c.z), bflo(c.w), bfhi(c.w)};
    const float cs[8] = {c0.x, c0.y, c0.z, c0.w, c1.x, c1.y, c1.z, c1.w}, sn[8] = {s0.x, s0.y, s0.z, s0.w, s1.x, s1.y, s1.z, s1.w};
#pragma unroll
    for (int e = 0; e < 8; ++e) { o1[e] = (x1[e] * cs[e] - x2[e] * sn[e]) * scale; o2[e] = (x2[e] * cs[e] + x1[e] * sn[e]) * scale; }
}
__device__ __forceinline__ bf16x8 pack8(const float (&o)[8]) { const u32x4 w = (u32x4){pk2(o[0], o[1]), pk2(o[2], o[3]), pk2(o[4], o[5]), pk2(o[6], o[7])}; return __builtin_bit_cast(bf16x8, w); }
__device__ __forceinline__ void stage_vt(LAS bf16* Vt, const bf16* u, size_t tok0, int tid) {
    for (int i = tid; i < 64 * 48; i += NT) { const int j = i & 63, cg8 = i >> 6; const u32x4 v = *(const u32x4*)(u + (tok0 + j) * DINP + U_RV + cg8 * 8); scatter8(Vt, cg8 * 8, j, v); }
}
__device__ __forceinline__ void retkv_unit(LAS unsigned char* lds, const bf16* u, float* kv, int b, int n, int tid, int wid, int lane) {
    const int fr = lane & 15, fq = lane >> 4;
    LAS bf16* Vt = (LAS bf16*)lds; LAS bf16* Kt = Vt + 384 * VTS;
    const size_t tok0 = (size_t)b * SEQ + n * 64;
    LDS_BARRIER();
    stage_vt(Vt, u, tok0, tid);
    for (int i = tid; i < 64 * 48; i += NT) { const int j = i & 63, cg8 = i >> 6, h = cg8 >> 3; const u32x4 a = *(const u32x4*)(u + (tok0 + j) * DINP + U_RK + cg8 * 8);
        const float z = fexp2((float)(63 - j) * ret_logg2(h));
        const u32x4 w = (u32x4){pk2(bflo(a.x) * z, bfhi(a.x) * z), pk2(bflo(a.y) * z, bfhi(a.y) * z), pk2(bflo(a.z) * z, bfhi(a.z) * z), pk2(bflo(a.w) * z, bfhi(a.w) * z)};
        scatter8(Kt, cg8 * 8, j, w); }
    LDS_BARRIER();
    for (int t = wid; t < 24; t += NWAVES) { const int h = t >> 2, et = t & 3;
        bf16x8 Va[2];
#pragma unroll
        for (int ks = 0; ks < 2; ++ks) Va[ks] = *(const LAS bf16x8*)(Vt + (h * 64 + et * 16 + fr) * VTS + ks * 32 + 8 * fq);
        float* dst = kv + (((size_t)b * NC + n) * RH + h) * 4096;
#pragma unroll
        for (int dt = 0; dt < 4; ++dt) { f32x4 acc = (f32x4){0.f, 0.f, 0.f, 0.f};
#pragma unroll
            for (int ks = 0; ks < 2; ++ks) { const bf16x8 Kb = *(const LAS bf16x8*)(Kt + (h * 64 + dt * 16 + fr) * VTS + ks * 32 + 8 * fq); acc = MFMA16(Va[ks], Kb, acc); }
#pragma unroll
            for (int r = 0; r < 4; ++r) dst[(et * 16 + 4 * fq + r) * 64 + dt * 16 + fr] = acc[r]; }
    }
}
__device__ __forceinline__ void scan_phase(const float* kv, bf16* state, int bx, int G, int tid) {
    constexpr int TOT = BATCH * RH * 4096;
    const int per_b = (TOT + G - 1) / G;
    for (int e = tid; e < per_b; e += NT) { const int g = bx * per_b + e; if (g >= TOT) break;
        const int ed = g & 4095, bh = g >> 12, h = bh % RH, b = bh / RH;
        const float gc = fexp2(64.f * ret_logg2(h)); float S = 0.f;
#pragma unroll 8
        for (int n = 0; n < NC; ++n) { const size_t idx = (((size_t)b * NC + n) * RH + h) * 4096 + ed; const float v = kv[idx]; state[idx] = (bf16)(pk2(S, 0.f) & 0xffffu); S = S * gc + v; }
    }
}
__device__ __forceinline__ void retout_unit(LAS unsigned char* lds, const bf16* u, const bf16* state, bf16* ymix, int b, int n, int tid, int wid, int lane) {
    const int fr = lane & 15, fq = lane >> 4;
    LAS bf16* Vt = (LAS bf16*)lds;
    const size_t tok0 = (size_t)b * SEQ + n * 64;
    LDS_BARRIER();
    stage_vt(Vt, u, tok0, tid);
    LDS_BARRIER();
    for (int t = wid; t < 24; t += NWAVES) { const int h = t >> 2, ig = t & 3; const float lg2 = ret_logg2(h);
        const size_t tok_i = tok0 + ig * 16 + fr;
        bf16x8 Qb[2];
#pragma unroll
        for (int ks = 0; ks < 2; ++ks) Qb[ks] = *(const bf16x8*)(u + tok_i * DINP + U_RQ + h * 64 + ks * 32 + 8 * fq);
        u32x2 gw2[4];
#pragma unroll
        for (int et = 0; et < 4; ++et) gw2[et] = *(const u32x2*)(u + tok_i * DINP + U_RG + h * 64 + et * 16 + 4 * fq);
        f32x4 y[4];
        const bf16* sp = state + (((size_t)b * NC + n) * RH + h) * 4096;
        const float xi = fexp2((float)(ig * 16 + fr + 1) * lg2);
#pragma unroll
        for (int et = 0; et < 4; ++et) { y[et] = (f32x4){0.f, 0.f, 0.f, 0.f};
#pragma unroll
            for (int ks = 0; ks < 2; ++ks) { const bf16x8 Sa = *(const bf16x8*)(sp + (et * 16 + fr) * 64 + ks * 32 + 8 * fq); y[et] = MFMA16(Sa, Qb[ks], y[et]); }
            y[et] = y[et] * xi; }
        f32x4 sc[4];
#pragma unroll
        for (int jt = 0; jt < 4; ++jt) { sc[jt] = (f32x4){0.f, 0.f, 0.f, 0.f};
            if (jt <= ig) {
#pragma unroll
                for (int ks = 0; ks < 2; ++ks) { const bf16x8 Ka = *(const bf16x8*)(u + (tok0 + jt * 16 + fr) * DINP + U_RK + h * 64 + ks * 32 + 8 * fq); sc[jt] = MFMA16(Ka, Qb[ks], sc[jt]); }
#pragma unroll
                for (int r = 0; r < 4; ++r) { const int dlt = (ig * 16 + fr) - (jt * 16 + 4 * fq + r); sc[jt][r] = dlt >= 0 ? sc[jt][r] * fexp2((float)dlt * lg2) : 0.f; }
            } }
#pragma unroll
        for (int kk = 0; kk < 2; ++kk) { const bf16x8 pb = pack_p(sc[2 * kk], sc[2 * kk + 1]);
#pragma unroll
            for (int et = 0; et < 4; ++et) { const bf16x8 Va = ld_tr_pair(Vt, h * 64 + et * 16 + fr, 32 * kk + 4 * fq, 32 * kk + 16 + 4 * fq); y[et] = MFMA16(Va, pb, y[et]); } }
        float sm = 0.f;
#pragma unroll
        for (int et = 0; et < 4; ++et) sm += (y[et][0] + y[et][1]) + (y[et][2] + y[et][3]);
        sm += __shfl_xor(sm, 16); sm += __shfl_xor(sm, 32);
        const float mean = sm * (1.f / 64.f); float q = 0.f;
#pragma unroll
        for (int et = 0; et < 4; ++et) { y[et] = y[et] - mean; q += (y[et][0] * y[et][0] + y[et][1] * y[et][1]) + (y[et][2] * y[et][2] + y[et][3] * y[et][3]); }
        q += __shfl_xor(q, 16); q += __shfl_xor(q, 32);
        const float rstd = rsqrtf(q * (1.f / 64.f) + EPS);
#pragma unroll
        for (int et = 0; et < 4; ++et) {
            const float g0 = bflo(gw2[et].x), g1 = bfhi(gw2[et].x), g2 = bflo(gw2[et].y), g3 = bfhi(gw2[et].y);
            u32x2 o; o.x = pk2(g0 * sigmoidf_(g0) * y[et][0] * rstd, g1 * sigmoidf_(g1) * y[et][1] * rstd); o.y = pk2(g2 * sigmoidf_(g2) * y[et][2] * rstd, g3 * sigmoidf_(g3) * y[et][3] * rstd);
            *(u32x2*)(ymix + tok_i * DM + Y_RET + h * 64 + et * 16 + 4 * fq) = o; }
    }
}

#define XB_TMO      128
#define XB_XCNT(j)  (256  + 64 * (j))
#define XB_XSUB(j)  (1280 + 64 * (j))
#define XB_XGEN(j)  (2304 + 64 * (j))
#define XB_TOP      3328
#define XB_TOPGEN   3392
#define XCD_BAR_WORDS 3456
#define XB_SPIN_CAP (1u << 18)

__device__ __forceinline__ unsigned xb_ld(unsigned* p)              { return __hip_atomic_load(p, __ATOMIC_RELAXED, __HIP_MEMORY_SCOPE_AGENT); }
__device__ __forceinline__ unsigned xb_add(unsigned* p, unsigned v) { return __hip_atomic_fetch_add(p, v, __ATOMIC_RELAXED, __HIP_MEMORY_SCOPE_AGENT); }
__device__ __forceinline__ unsigned xb_xcc_id() { return (unsigned)__builtin_amdgcn_s_getreg((3 << 11) | 20) & 0xFu; }
#define XB_SPIN(cond, bar) do { unsigned _sp = 0; while (cond) { __builtin_amdgcn_s_sleep(1); \
    if ((++_sp & 255u) == 0u) { if (xb_ld(&(bar)[XB_TMO])) break; if (_sp > XB_SPIN_CAP) { atomicAdd(&(bar)[XB_TMO], 1u); break; } } } } while (0)

struct XcdBarrier {
    unsigned* bar; unsigned x;
    volatile LAS unsigned* st;
};

__device__ __forceinline__ XcdBarrier xcd_barrier_post(unsigned* bar, volatile LAS unsigned* st) {
    XcdBarrier b; b.bar = bar; b.x = xb_xcc_id(); b.st = st;
    if (threadIdx.x == 0) (void)xb_add(&bar[XB_XCNT(b.x)], 1u);
    return b;
}
__device__ __forceinline__ void xcd_barrier_complete(unsigned* bar, unsigned x, unsigned& nloc, unsigned& nx) {
    const unsigned G = gridDim.x * gridDim.y * gridDim.z;
    unsigned sum, cnt, mine, sp = 0u;
    for (;;) {
        sum = 0u; cnt = 0u; mine = 0u;
#pragma unroll
        for (unsigned j = 0; j < 16; ++j) { const unsigned c = xb_ld(&bar[XB_XCNT(j)]); sum += c; cnt += (c > 0u) ? 1u : 0u; mine = (j == x) ? c : mine; }
        if (sum == G) break;
        __builtin_amdgcn_s_sleep(1);
        if ((++sp & 255u) == 0u) { if (xb_ld(&bar[XB_TMO])) break; if (sp > XB_SPIN_CAP) { atomicAdd(&bar[XB_TMO], 1u); break; } }
    }
    nloc = mine > 0u ? mine : 1u; nx = cnt > 0u ? cnt : 1u;
}

__device__ __forceinline__ void xcd_barrier(const XcdBarrier& b) {
    asm volatile("s_waitcnt vmcnt(0)" ::: "memory");
    __syncthreads();
    if (threadIdx.x == 0) {
        unsigned* bar = b.bar;
        __builtin_amdgcn_s_waitcnt(0);
        unsigned nloc = b.st[0], nx = b.st[1];
        if (nloc == 0u) { xcd_barrier_complete(bar, b.x, nloc, nx); b.st[0] = nloc; b.st[1] = nx; }
        const unsigned old = xb_add(&bar[XB_XSUB(b.x)], 1u);
        const unsigned gen = old / nloc;
        if (old + 1u == (gen + 1u) * nloc) {
            __builtin_amdgcn_fence(__ATOMIC_RELEASE, "agent");
            asm volatile("s_waitcnt vmcnt(0)" ::: "memory");
            const unsigned og = xb_add(&bar[XB_TOP], 1u);
            const unsigned tg = og / nx;
            if (og + 1u == (tg + 1u) * nx) xb_add(&bar[XB_TOPGEN], 1u);
            else XB_SPIN(xb_ld(&bar[XB_TOPGEN]) == tg, bar);
            __builtin_amdgcn_fence(__ATOMIC_ACQUIRE, "agent");
            xb_add(&bar[XB_XGEN(b.x)], 1u);
            asm volatile("s_waitcnt vmcnt(0)" ::: "memory");
        } else {
            XB_SPIN(xb_ld(&bar[XB_XGEN(b.x)]) == gen, bar);
            __builtin_amdgcn_fence(__ATOMIC_ACQUIRE, "agent");
            asm volatile("s_waitcnt vmcnt(0)" ::: "memory");
        }
    }
    __syncthreads();
}

#ifndef PROBE
#define PROBE 0
#endif
#define REP(bit) for (int rep_ = 0; rep_ < ((PROBE & (bit)) ? 2 : 1); ++rep_)
constexpr int N_PHASES = 1 + 9 * DEPTH;
#define IN(k) (lo <= (k) && (k) < hi)
#ifdef NO_SYNC
#define SEAM(k) do { } while (0)
#else
#define SEAM(k) do { if (lo <= (k) && (k) + 1 < hi) { REP(32) { xcd_barrier(bar); } } } while (0)
#endif
template <int l> __device__ __forceinline__ void layer_phases(const Args& a, LAS unsigned char* lds, const XcdBarrier& bar, int lo, int hi, int tid, int lane, int wid, int G, int bx, int gw, int NGW) {
    unsigned char* ws = a.ws;
    bf16* Hb = (bf16*)(ws + WS_H); bf16* MIXb = (bf16*)(ws + WS_MIX); bf16* Ub = (bf16*)(ws + WS_U); bf16* YM = (bf16*)(ws + WS_YMIX); bf16* F1 = (bf16*)(ws + WS_F1);
    float* KV = (float*)(ws + WS_KV); bf16* STt = (bf16*)(ws + WS_ST);
    const float* ct = (const float*)(ws + WS_ROPE); const float* st = ct + SEQ * 32;
        const int pb = 1 + 9 * l;
        if (IN(pb + 0)) {
#ifndef NO_GEMM
            const pg8::Gemm g{Hb, (const bf16*)(ws + WS_WIN) + (size_t)l * DINP * DM, M, DINP, DM}; const pg8::EpiOut E{Ub, DINP, 2, ct, st, U_RQ, U_RV, U_RK, SEQ};
            pg8::StaticOrder S; S.init(M, DINP, G, bx);
            REP(128) pg8::gemm_phase<pg8::EpiOut, pg8::StaticOrder, true, true>(lds, g, S, E);
#endif
        }
        SEAM(pb + 0);
        if (IN(pb + 1)) {
#ifndef NO_RETKV
            for (int it = bx; it < 512; it += G) { REP(4) retkv_unit(lds, Ub, KV, it / NC, it % NC, tid, wid, lane); }
#endif
        }
        SEAM(pb + 1);
        if (IN(pb + 2)) {
            REP(8) scan_phase(KV, STt, bx, G, tid);
            const float* relb = a.rel_bias + (size_t)l * AH * 257;
            if ((G & 7) == 0) {
#ifndef NO_ATTN
                const int per_x = G >> 3, xx = bx & 7, cc = bx >> 3;
                for (int idx = cc; idx < 192; idx += per_x) { const int id = xx * 192 + idx; const int bh = id >> 7, n = id & 127;
                    REP(1) attn_unit(lds, Ub, relb, YM, bh / 3, n, bh % 3, tid, wid, lane); }
#endif
            } else {
                for (int it = bx; it < 1536; it += G) { const int hp = it % 3, bn = it / 3; attn_unit(lds, Ub, relb, YM, bn / NC, bn % NC, hp, tid, wid, lane); }
            }
#ifndef NO_CONV
            for (int it = bx; it < 512; it += G) { REP(2) conv_unit(lds, Ub, a.conv_w + (size_t)l * CK * CW, a.conv_b + l * CW, a.conv_ln_g + l * CW, a.conv_ln_b + l * CW, YM, it / NC, it % NC, tid, wid, lane); }
#endif
        }
        SEAM(pb + 2);
        if (IN(pb + 3)) {
#ifndef NO_RETOUT
            REP(16) for (int it = bx; it < 512; it += G) retout_unit(lds, Ub, STt, YM, it / NC, it % NC, tid, wid, lane);
#endif
        }
        SEAM(pb + 3);
        if (IN(pb + 4)) {
#ifndef NO_GEMM
            const pg8::Gemm g{YM, (const bf16*)(ws + WS_WOUT) + (size_t)l * DM * DM, M, DM, DM}; const pg8::EpiOut E{MIXb, DM, 0, nullptr, nullptr, 0, 0, 0, 1};
            pg8::StaticOrder S; S.init(M, DM, G, bx);
            REP(128) pg8::gemm_phase<pg8::EpiOut, pg8::StaticOrder, true, true>(lds, g, S, E);
#endif
        }
        SEAM(pb + 4);
        if (IN(pb + 5)) ephase(l == 0 ? a.x : a.out, MIXb, a.g_mix_post + l * DM, a.g_mlp_pre + l * DM, a.out, Hb, gw, NGW, lane);
        SEAM(pb + 5);
        if (IN(pb + 6)) {
#ifndef NO_GEMM
            const pg8::Gemm g{Hb, (const bf16*)(ws + WS_WUP) + (size_t)l * DFF * DM, M, DFF, DM}; const pg8::EpiOut E{F1, DFF, 1, nullptr, nullptr, 0, 0, 0, 1};
            pg8::StaticOrder S; S.init(M, DFF, G, bx);
            REP(128) pg8::gemm_phase<pg8::EpiOut, pg8::StaticOrder, true, true>(lds, g, S, E);
#endif
        }
        SEAM(pb + 6);
        if (IN(pb + 7)) {
#ifndef NO_GEMM
            const pg8::Gemm g{F1, (const bf16*)(ws + WS_WDN) + (size_t)l * DM * DFF, M, DM, DFF}; const pg8::EpiOut E{MIXb, DM, 0, nullptr, nullptr, 0, 0, 0, 1};
            pg8::StaticOrder S; S.init(M, DM, G, bx);
            REP(128) pg8::gemm_phase<pg8::EpiOut, pg8::StaticOrder, true, true>(lds, g, S, E);
#endif
        }
        SEAM(pb + 7);
        if (IN(pb + 8)) ephase(a.out, MIXb, a.g_mlp_post + l * DM, (l + 1 < DEPTH) ? a.g_mix_pre + (l + 1) * DM : nullptr, a.out, Hb, gw, NGW, lane);
        SEAM(pb + 8);
    }
__global__ void __launch_bounds__(NT, 2) fwd_kernel(Args a) {
    extern __shared__ __attribute__((aligned(16))) unsigned char lds_raw[];
    LAS unsigned char* lds = (LAS unsigned char*)lds_raw;
    const int tid = threadIdx.x, lane = tid & 63, wid = __builtin_amdgcn_readfirstlane(tid >> 6);
    const int G = gridDim.x, bx = blockIdx.x;
    const int gw = bx * NWAVES + wid, NGW = G * NWAVES;
    unsigned char* ws = a.ws;
    bf16* Hb = (bf16*)(ws + WS_H); bf16* MIXb = (bf16*)(ws + WS_MIX); bf16* Ub = (bf16*)(ws + WS_U); bf16* YM = (bf16*)(ws + WS_YMIX); bf16* F1 = (bf16*)(ws + WS_F1);
    float* KV = (float*)(ws + WS_KV); bf16* STt = (bf16*)(ws + WS_ST);
    const float* ct = (const float*)(ws + WS_ROPE); const float* st = ct + SEQ * 32;
    const int lo = a.ph_lo, hi = a.ph_hi;
    volatile LAS unsigned* stw = (volatile LAS unsigned*)(lds + 131072 + 64);
    unsigned* barw = (unsigned*)ws;
    if (tid < 2) stw[tid] = 0u;
    if (bx == 0) for (int i = tid; i < XCD_BAR_WORDS; i += NT) barw[i] = 0u;
    __syncthreads();
    if (IN(0)) REP(64) prologue(a, lds, gw, NGW, wid, lane);
    __syncthreads(); cg::this_grid().sync();
    const XcdBarrier bar = xcd_barrier_post(barw, stw);
    layer_phases<0>(a, lds, bar, lo, hi, tid, lane, wid, G, bx, gw, NGW);
    layer_phases<1>(a, lds, bar, lo, hi, tid, lane, wid, G, bx, gw, NGW);
}
#undef IN
#undef SEAM


#ifndef MULTI_LAUNCH
#define MULTI_LAUNCH 0
#endif
extern "C" void kernel_launch(void* const* d_in, const int* in_sizes, int n_in, void* d_out, int out_size, void* d_ws, size_t ws_size, hipStream_t stream) {
    static int grid = 0;
    if (grid == 0) {
        if (n_in != 14 || in_sizes[0] != M * DM || out_size != M * DM || ws_size < WS_END) { fprintf(stderr, "kernel_launch: unexpected shapes: n_in %d in0 %d out %d ws %zu\n", n_in, n_in > 0 ? in_sizes[0] : -1, out_size, ws_size); grid = -1; return; }
        int dev = 0, cus = 0, per_cu = 0;
        hipGetDevice(&dev); hipDeviceGetAttribute(&cus, hipDeviceAttributeMultiprocessorCount, dev);
        if (hipFuncSetAttribute((const void*)fwd_kernel, hipFuncAttributeMaxDynamicSharedMemorySize, LDS_BYTES) != hipSuccess) { fprintf(stderr, "kernel_launch: hipFuncSetAttribute failed\n"); grid = -1; return; }
        if (hipOccupancyMaxActiveBlocksPerMultiprocessor(&per_cu, (const void*)fwd_kernel, NT, LDS_BYTES) != hipSuccess || per_cu < 1) { fprintf(stderr, "kernel_launch: occupancy query says %d\n", per_cu); per_cu = 1; }
        (void)hipGetLastError();
        grid = cus * 1;
        fprintf(stderr, "kernel_launch: cus %d per_cu %d grid %d\n", cus, per_cu, grid);
    }
    if (grid < 0) return;
    Args a{};
    a.x = (const float*)d_in[0]; a.g_mix_pre = (const float*)d_in[1]; a.g_mix_post = (const float*)d_in[2]; a.g_mlp_pre = (const float*)d_in[3]; a.g_mlp_post = (const float*)d_in[4];
    a.w_in = (const float*)d_in[5]; a.rel_bias = (const float*)d_in[6]; a.conv_w = (const float*)d_in[7]; a.conv_b = (const float*)d_in[8]; a.conv_ln_g = (const float*)d_in[9]; a.conv_ln_b = (const float*)d_in[10];
    a.w_out = (const float*)d_in[11]; a.w_up = (const float*)d_in[12]; a.w_down = (const float*)d_in[13];
    a.out = (float*)d_out; a.ws = (unsigned char*)d_ws;
#if MULTI_LAUNCH
    for (int ph = 0; ph < N_PHASES; ++ph) { a.ph_lo = ph; a.ph_hi = ph + 1; hipLaunchKernelGGL(fwd_kernel, dim3(grid), dim3(NT), LDS_BYTES, stream, a); }
#else
    a.ph_lo = 0; a.ph_hi = N_PHASES;
    void* args[] = {&a};
    hipError_t e = hipLaunchCooperativeKernel((const void*)fwd_kernel, dim3(grid), dim3(NT), args, LDS_BYTES, stream);
    if (e != hipSuccess) fprintf(stderr, "cooperative launch failed: %s (grid %d)\n", hipGetErrorString(e), grid);
#endif
}
```

```cpp
#include <hip/hip_runtime.h>
#include <hip/hip_cooperative_groups.h>
#include <cstdio>
#include <cstdint>
#include <cmath>
namespace cg = cooperative_groups;
namespace pg8 {
#define PG8_LAS __attribute__((address_space(3)))
typedef unsigned short bf16_t;
typedef short bf16x8 __attribute__((ext_vector_type(8)));
typedef float f32x4 __attribute__((ext_vector_type(4)));
typedef unsigned u32x4 __attribute__((ext_vector_type(4)));
constexpr int BM = 256, BK = 64, HALF = 128, HTB = HALF * BK * 2  , STAGE_BYTES = 8 * HTB, NXCD = 8, WGM = 8;

__host__ __device__ __forceinline__ int lds_byte(int r, int c) { const int st = (r >> 4) * 2 + (c >> 5), rr = r & 15, cc = c & 31, ob = rr * 64 + cc * 2; return st * 1024 + (ob ^ (((ob >> 9) & 1) << 5)); }
__host__ __device__ __forceinline__ void stage_rc(int b, int& R, int& C) { const int st = b / 1024, sb = b % 1024, swz = sb ^ (((sb >> 9) & 1) << 5); R = (st >> 1) * 16 + swz / 64; C = (st & 1) * 32 + (swz % 64) / 2; }
__host__ __device__ __forceinline__ int perm32(int rho) { const int n = rho >> 4, i = rho & 15; return 8 * (i >> 2) + 4 * n + (i & 3); }

struct Unit { int pm, pn; };
struct Gemm { const bf16_t* A; const bf16_t* Bt; int M, N, K; };

struct StaticOrder {
    int nM, nN, nwg, G, c;
    __host__ __device__ void init(int M, int N, int G_, int c_) { nM = M / BM; nN = N / BM; nwg = nM * nN; G = G_; c = c_; }
    __host__ __device__ bool next(int i, Unit& u) const {
        const long L = (long)i * G + c; if (L >= nwg) return false;
        int wgid = (int)L; { const int q = nwg / NXCD, r = nwg % NXCD, xcd = wgid % NXCD, off = wgid / NXCD; wgid = (xcd < r ? xcd * (q + 1) : r * (q + 1) + (xcd - r) * q) + off; }
        const int nig = WGM * nN, gid = wgid / nig, fm = gid * WGM, gsz = (nM - fm) < WGM ? (nM - fm) : WGM;
        u.pm = fm + ((wgid % nig) % gsz); u.pn = (wgid % nig) / gsz; return true;
    }
    __device__ __forceinline__ void a_ready(const Unit&) const {}
    __device__ __forceinline__ void done(const Unit&) const {}
};


__device__ __forceinline__ unsigned cvt_pk_bf16(float lo, float hi) { unsigned r; asm volatile("v_cvt_pk_bf16_f32 %0, %1, %2" : "=v"(r) : "v"(lo), "v"(hi)); return r; }
struct EpiOut {
    static constexpr bool PERM = true, AFTER_DRAIN = false;
    bf16_t* O; int ldc; int act;
    const float* ct; const float* st; int rope_lo, rope_hi, rope_k, seq;
    const float* rs;
    __device__ __forceinline__ void operator()(const f32x4 (&acc)[2][2][4][2], const Unit& u, int wr, int wc, int fr, int fq) const {
        const int row0 = u.pm * BM + wr * 64 + fr; const int col0 = u.pn * BM + wc * 32 + 8 * fq;
#pragma unroll
        for (int ai = 0; ai < 2; ++ai)
#pragma unroll
            for (int m = 0; m < 4; ++m) { const int row = row0 + ai * HALF + m * 16; bf16_t* rowp = O + (size_t)row * ldc + col0; const float rsv = rs ? rs[row] : 1.f;
#pragma unroll
                for (int bj = 0; bj < 2; ++bj) { f32x4 v0 = acc[ai][bj][m][0] * rsv, v1 = acc[ai][bj][m][1] * rsv;
                    if (act == 1) {
#pragma unroll
                        for (int e = 0; e < 4; ++e) { float a = fmaxf(v0[e], 0.f), b = fmaxf(v1[e], 0.f); v0[e] = a * a; v1[e] = b * b; } }
                    if (act == 2) { const int cb = u.pn * BM + wc * 32 + bj * HALF;
                        if (cb >= rope_lo && cb < rope_hi) { const int pos = row % seq, g = ((col0 + bj * HALF) & 63) >> 3;
                            const f32x4 c = *(const f32x4*)(ct + pos * 32 + 4 * g), sn = *(const f32x4*)(st + pos * 32 + 4 * g); const float sc = cb >= rope_k ? 0.125f : 1.f;
                            const f32x4 x1 = v0, x2 = v1; v0 = (x1 * c - x2 * sn) * sc; v1 = (x2 * c + x1 * sn) * sc; } }
                    u32x4 w; w.x = cvt_pk_bf16(v0[0], v0[1]); w.y = cvt_pk_bf16(v0[2], v0[3]); w.z = cvt_pk_bf16(v1[0], v1[1]); w.w = cvt_pk_bf16(v1[2], v1[3]);
                    *(u32x4*)(rowp + bj * HALF) = w; } }
    }
};

template <class Epi, class Sched, bool ALIGN_EPI = false, bool SP2 = false>
__device__ __forceinline__ void gemm_phase(PG8_LAS unsigned char* lds, const Gemm g, const Sched& S, const Epi& E) {
    const int tid = threadIdx.x, wid = __builtin_amdgcn_readfirstlane(tid >> 6), lane = tid & 63, wr = wid >> 2, wc = wid & 3, fr = lane & 15, fq = lane >> 4;
    const int K = g.K, nt = K / BK;
    unsigned voffA[2], voffB[2];
#pragma unroll
    for (int i = 0; i < 2; ++i) { int R, C; stage_rc(tid * 16 + i * 8192, R, C); const int Rb = Epi::PERM ? ((R & ~31) + perm32(R & 31)) : R;
        voffA[i] = (unsigned)(R * K + C) * 2u; voffB[i] = (unsigned)(Rb * K + C) * 2u; }
    const size_t kstep = (size_t)(BK * 2);
    const size_t hstep = (size_t)HALF * K * 2;
    const size_t tstep = 2 * hstep;
    const unsigned ldsw = (unsigned)wid * 1024u;
    const int aoff = lds_byte(wr * 64 + fr, fq * 8), boff = lds_byte(wc * 32 + fr, fq * 8);
#define PG8_SA(b, h) (((b) * 2 + (h)) * HTB)
#define PG8_SB(b, h) ((4 + (b) * 2 + (h)) * HTB)
#define PG8_STAGE(bufoff, gbase, voff) do { _Pragma("unroll") for (int _i = 0; _i < 2; ++_i) \
        __builtin_amdgcn_global_load_lds((const unsigned*)((const char*)(gbase) + (voff)[_i]), (PG8_LAS unsigned*)(lds + (bufoff) + ldsw + _i * 8192), 16, 0, 0); } while (0)
#define PG8_LDA(dst, b, h) do { _Pragma("unroll") for (int m = 0; m < 4; ++m) _Pragma("unroll") for (int k = 0; k < 2; ++k) dst[m][k] = *(const PG8_LAS bf16x8*)(lds + PG8_SA(b, h) + aoff + m * 2048 + k * 1024); } while (0)
#define PG8_LDB(dst, b, h) do { _Pragma("unroll") for (int n = 0; n < 2; ++n) _Pragma("unroll") for (int k = 0; k < 2; ++k) dst[n][k] = *(const PG8_LAS bf16x8*)(lds + PG8_SB(b, h) + boff + n * 2048 + k * 1024); } while (0)
#define PG8_MMA(ai, bj, At, Bt) do { __builtin_amdgcn_s_setprio(1); _Pragma("unroll") for (int m = 0; m < 4; ++m) _Pragma("unroll") for (int n = 0; n < 2; ++n) _Pragma("unroll") for (int k = 0; k < 2; ++k) \
        acc[ai][bj][m][n] = __builtin_amdgcn_mfma_f32_16x16x32_bf16(Bt[n][k], At[m][k], acc[ai][bj][m][n], 0, 0, 0); __builtin_amdgcn_s_setprio(0); } while (0)
#define PG8_WAIT_V(n) asm volatile("s_waitcnt vmcnt(" #n ")" ::: "memory")
#define PG8_WAIT_L(n) asm volatile("s_waitcnt lgkmcnt(" #n ")" ::: "memory")
#define PG8_BAR __builtin_amdgcn_s_barrier()
#define PG8_SCHED __builtin_amdgcn_sched_barrier(0)
    Unit cur, nxt; int ui = 0;
    if (!S.next(0, cur)) return;
    f32x4 acc[2][2][4][2];
#pragma unroll
    for (int a = 0; a < 2; ++a)
#pragma unroll
        for (int b = 0; b < 2; ++b)
#pragma unroll
            for (int m = 0; m < 4; ++m)
#pragma unroll
                for (int n = 0; n < 2; ++n) acc[a][b][m][n] = (f32x4){0.f, 0.f, 0.f, 0.f};
    bf16x8 At[4][2], B0[2][2], B1[2][2];
    const char* cA = (const char*)g.A + (size_t)cur.pm * tstep; const char* cB = (const char*)g.Bt + (size_t)cur.pn * tstep;
    S.a_ready(cur);
    if constexpr (SP2) {
        PG8_STAGE(PG8_SB(0, 0), cB, voffB); PG8_STAGE(PG8_SB(0, 1), cB + hstep, voffB); PG8_STAGE(PG8_SA(0, 0), cA, voffA); PG8_STAGE(PG8_SA(0, 1), cA + hstep, voffA);
        if (wr == 1) PG8_BAR;
        PG8_WAIT_V(2); PG8_BAR;
        PG8_STAGE(PG8_SB(1, 0), cB + kstep, voffB); PG8_STAGE(PG8_SA(1, 0), cA + kstep, voffA); PG8_STAGE(PG8_SB(1, 1), cB + hstep + kstep, voffB);
        PG8_WAIT_V(6); PG8_BAR;
    } else {
        PG8_STAGE(PG8_SB(0, 0), cB, voffB); PG8_STAGE(PG8_SA(0, 0), cA, voffA); PG8_STAGE(PG8_SB(0, 1), cB + hstep, voffB); PG8_STAGE(PG8_SA(0, 1), cA + hstep, voffA);
        if (wr == 1) PG8_BAR;
        PG8_WAIT_V(4); PG8_BAR;
        PG8_STAGE(PG8_SB(1, 0), cB + kstep, voffB); PG8_STAGE(PG8_SA(1, 0), cA + kstep, voffA); PG8_STAGE(PG8_SB(1, 1), cB + hstep + kstep, voffB);
        PG8_WAIT_V(6); PG8_BAR;
    }
    for (;;) {
        const bool has_next = S.next(ui + 1, nxt);
        const char* nA = has_next ? (const char*)g.A + (size_t)nxt.pm * tstep : cA; const char* nB = has_next ? (const char*)g.Bt + (size_t)nxt.pn * tstep : cB;
        for (int t = 0; t < nt; t += 2) {
            const bool last = (t == nt - 2);
            const char* a1 = cA + (size_t)(t + 1) * kstep;
            const char* a2 = last ? nA : cA + (size_t)(t + 2) * kstep; const char* b2 = last ? nB : cB + (size_t)(t + 2) * kstep;
            const char* a3 = a2 + kstep; const char* b3 = b2 + kstep;
            if (last && has_next) S.a_ready(nxt);
            if constexpr (SP2) {
            PG8_LDB(B0, 0, 0); PG8_LDB(B1, 0, 1); PG8_SCHED; PG8_LDA(At, 0, 0); PG8_STAGE(PG8_SA(1, 1), a1 + hstep, voffA);
            PG8_WAIT_V(8); PG8_WAIT_L(0); PG8_BAR; PG8_MMA(0, 0, At, B0); PG8_MMA(0, 1, At, B1); PG8_BAR; PG8_SCHED;
            PG8_LDA(At, 0, 1); PG8_STAGE(PG8_SB(0, 0), b2, voffB); PG8_STAGE(PG8_SB(0, 1), b2 + hstep, voffB); PG8_STAGE(PG8_SA(0, 0), a2, voffA);
            PG8_WAIT_V(8); PG8_WAIT_L(0); PG8_BAR; PG8_MMA(1, 0, At, B0); PG8_MMA(1, 1, At, B1); PG8_BAR; PG8_SCHED;
            PG8_LDB(B0, 1, 0); PG8_LDB(B1, 1, 1); PG8_SCHED; PG8_LDA(At, 1, 0); PG8_STAGE(PG8_SA(0, 1), a2 + hstep, voffA);
            PG8_WAIT_V(8); PG8_WAIT_L(0); PG8_BAR; PG8_MMA(0, 0, At, B0); PG8_MMA(0, 1, At, B1); PG8_BAR; PG8_SCHED;
            PG8_LDA(At, 1, 1); PG8_STAGE(PG8_SB(1, 0), b3, voffB); PG8_STAGE(PG8_SB(1, 1), b3 + hstep, voffB); PG8_STAGE(PG8_SA(1, 0), a3, voffA);
            PG8_WAIT_V(8); PG8_WAIT_L(0); PG8_BAR; PG8_MMA(1, 0, At, B0); PG8_MMA(1, 1, At, B1); PG8_BAR; PG8_SCHED;
            } else {
            PG8_LDB(B0, 0, 0); PG8_SCHED; PG8_LDA(At, 0, 0); PG8_STAGE(PG8_SA(1, 1), a1 + hstep, voffA);
            PG8_WAIT_L(8); PG8_BAR; PG8_WAIT_L(0); PG8_MMA(0, 0, At, B0); PG8_BAR; PG8_SCHED;
            PG8_LDB(B1, 0, 1); PG8_STAGE(PG8_SB(0, 0), b2, voffB);
            PG8_BAR; PG8_WAIT_L(0); PG8_MMA(0, 1, At, B1); PG8_BAR;
            PG8_LDA(At, 0, 1); PG8_STAGE(PG8_SA(0, 0), a2, voffA);
            PG8_BAR; PG8_WAIT_L(0); PG8_MMA(1, 0, At, B0); PG8_BAR; PG8_SCHED;
            PG8_STAGE(PG8_SB(0, 1), b2 + hstep, voffB);
            PG8_WAIT_V(6); PG8_BAR; PG8_MMA(1, 1, At, B1); PG8_BAR;
            PG8_LDB(B0, 1, 0); PG8_SCHED; PG8_LDA(At, 1, 0); PG8_STAGE(PG8_SA(0, 1), a2 + hstep, voffA);
            PG8_WAIT_L(8); PG8_BAR; PG8_WAIT_L(0); PG8_MMA(0, 0, At, B0); PG8_BAR; PG8_SCHED;
            PG8_LDB(B1, 1, 1); PG8_STAGE(PG8_SB(1, 0), b3, voffB);
            PG8_BAR; PG8_WAIT_L(0); PG8_MMA(0, 1, At, B1); PG8_BAR;
            PG8_LDA(At, 1, 1); PG8_STAGE(PG8_SA(1, 0), a3, voffA);
            PG8_BAR; PG8_WAIT_L(0); PG8_MMA(1, 0, At, B0); PG8_BAR; PG8_SCHED;
            PG8_STAGE(PG8_SB(1, 1), b3 + hstep, voffB);
            PG8_WAIT_V(6); PG8_BAR; PG8_MMA(1, 1, At, B1); PG8_BAR;
            }
        }
        if constexpr (ALIGN_EPI) { if (wr == 0) PG8_BAR; }
        if constexpr (!Epi::AFTER_DRAIN) { E(acc, cur, wr, wc, fr, fq); S.done(cur); }
        if (!has_next) break;
#pragma unroll
        for (int a = 0; a < 2; ++a)
#pragma unroll
            for (int b = 0; b < 2; ++b)
#pragma unroll
                for (int m = 0; m < 4; ++m)
#pragma unroll
                    for (int n = 0; n < 2; ++n) acc[a][b][m][n] = (f32x4){0.f, 0.f, 0.f, 0.f};
        cur = nxt; cA = nA; cB = nB; ++ui;
        if constexpr (ALIGN_EPI) { if (wr == 1) PG8_BAR; }
    }
    PG8_WAIT_V(0);
    if constexpr (!ALIGN_EPI) { if (wr == 0) PG8_BAR; }
    PG8_BAR;
    if constexpr (Epi::AFTER_DRAIN) { E.fused(acc, cur, wr, wc, fr, fq, lds, wid, lane); S.done(cur); }
#undef PG8_SA
#undef PG8_SB
#undef PG8_STAGE
#undef PG8_LDA
#undef PG8_LDB
#undef PG8_MMA
#undef PG8_WAIT_V
#undef PG8_WAIT_L
#undef PG8_BAR
#undef PG8_SCHED
}
}

#define LAS __attribute__((address_space(3)))
typedef unsigned short bf16;
typedef short bf16x8 __attribute__((ext_vector_type(8)));
typedef float f32x4 __attribute__((ext_vector_type(4)));
typedef unsigned u32x4 __attribute__((ext_vector_type(4)));
typedef unsigned u32x2 __attribute__((ext_vector_type(2)));
constexpr int NWAVES = 8, NT = 512;
constexpr int BATCH = 4, SEQ = 8192, DM = 1024, M = BATCH * SEQ, DEPTH = 2;
constexpr int NC = SEQ / 64, AH = 6, RH = 6, CW = 256, CK = 31;
constexpr int DIN = 3200, DINP = 3328, DFF = 4096;
constexpr int U_AQ = 0, U_AK = 384, U_AV = 768, U_CA = 1152, U_CG = 1408, U_RQ = 1664, U_RK = 2048, U_RV = 2432, U_RG = 2816;
constexpr int Y_ATT = 0, Y_CONV = 384, Y_RET = 640;
constexpr float EPS = 1e-6f, LOG2E = 1.4426950408889634f;
constexpr size_t MiB = 1u << 20;
constexpr size_t WS_RS = 512 * 1024;
constexpr size_t WS_ROPE = 1 * MiB;
constexpr size_t WS_WIN = 4 * MiB;
constexpr size_t WS_WOUT = 17 * MiB;
constexpr size_t WS_WUP = 21 * MiB;
constexpr size_t WS_WDN = 37 * MiB;
constexpr size_t WS_H = 54 * MiB;
constexpr size_t WS_MIX = 118 * MiB;
constexpr size_t WS_KV = 118 * MiB;
constexpr size_t WS_ST = 182 * MiB;
constexpr size_t WS_U = 240 * MiB;
constexpr size_t WS_YMIX = 448 * MiB;
constexpr size_t WS_F1 = 240 * MiB;
constexpr size_t WS_END = 512 * MiB;
constexpr int LDS_BYTES = 147456;

__device__ __forceinline__ float bflo(unsigned w) { return __uint_as_float(w << 16); }
__device__ __forceinline__ float bfhi(unsigned w) { return __uint_as_float(w & 0xffff0000u); }
__device__ __forceinline__ unsigned pk2(float lo, float hi) { return pg8::cvt_pk_bf16(lo, hi); }
__device__ __forceinline__ float wave_sum(float v) {
#pragma unroll
    for (int o = 1; o < 64; o <<= 1) v += __shfl_xor(v, o);
    return v;
}
__device__ __forceinline__ float fexp2(float x) { return __builtin_amdgcn_exp2f(x); }
__device__ __forceinline__ float sigmoidf_(float x) { return __builtin_amdgcn_rcpf(1.f + fexp2(-x * LOG2E)); }
#define LDS_BARRIER() do { asm volatile("s_waitcnt lgkmcnt(0)" ::: "memory"); __builtin_amdgcn_s_barrier(); asm volatile("" ::: "memory"); } while (0)
#define MFMA16(a, b, c) __builtin_amdgcn_mfma_f32_16x16x32_bf16((a), (b), (c), 0, 0, 0)

struct Args {
    const float* x; const float* g_mix_pre; const float* g_mix_post; const float* g_mlp_pre; const float* g_mlp_post;
    const float* w_in; const float* rel_bias; const float* conv_w; const float* conv_b; const float* conv_ln_g; const float* conv_ln_b;
    const float* w_out; const float* w_up; const float* w_down;
    float* out; unsigned char* ws;
    int ph_lo, ph_hi;
};

template <bool ROPEPERM> __device__ __forceinline__ void transpose_item(const float* W, const float* gk, int K, int N, bf16* WT, LAS float* scr, int item, int lane) {
    const int nblk = N / 32, kb = item / nblk, nb = item % nblk, k0 = 64 * kb, n0 = 32 * nb;
#pragma unroll 8
    for (int i = 0; i < 32; ++i) { const int kk = 2 * i + (lane >> 5); scr[kk * 33 + (lane & 31)] = W[(size_t)(k0 + kk) * N + n0 + (lane & 31)] * (gk ? gk[k0 + kk] : 1.f); }
    asm volatile("s_waitcnt lgkmcnt(0)" ::: "memory");
    const int c = lane & 7;
#pragma unroll
    for (int j = 0; j < 4; ++j) { const int n = (lane >> 3) + 8 * j; const LAS float* s = scr + (8 * c) * 33 + n;
        u32x4 o; o.x = pk2(s[0 * 33], s[1 * 33]); o.y = pk2(s[2 * 33], s[3 * 33]); o.z = pk2(s[4 * 33], s[5 * 33]); o.w = pk2(s[6 * 33], s[7 * 33]);
        int nr = n0 + n; if (ROPEPERM && nr >= U_RQ && nr < U_RV) { const int d = nr & 63; nr = (nr & ~63) + (d < 32 ? 8 * (d >> 2) + (d & 3) : 8 * ((d - 32) >> 2) + 4 + (d & 3)); }
        *(u32x4*)(WT + (size_t)nr * K + k0 + 8 * c) = o; }
    asm volatile("s_waitcnt lgkmcnt(0)" ::: "memory");
}
__device__ __forceinline__ void row_to_bf16_rs(const float* xrow, bf16* orow, float* rs, int lane) {
    const f32x4* xr = (const f32x4*)xrow + lane;
    f32x4 v[4]; float sq = 0.f;
#pragma unroll
    for (int j = 0; j < 4; ++j) { v[j] = xr[64 * j]; sq += (v[j].x * v[j].x + v[j].y * v[j].y) + (v[j].z * v[j].z + v[j].w * v[j].w); }
    const float r = rsqrtf(wave_sum(sq) * (1.f / DM) + EPS);
    u32x2* o8 = (u32x2*)orow + lane;
#pragma unroll
    for (int j = 0; j < 4; ++j) { u32x2 w; w.x = pk2(v[j].x, v[j].y); w.y = pk2(v[j].z, v[j].w); o8[64 * j] = w; }
    if (lane == 0) *rs = r;
}
__device__ __forceinline__ void prologue(const Args& a, LAS unsigned char* lds, int gw, int NGW, int wave, int lane) {
    unsigned char* ws = a.ws;
    LAS float* scr = (LAS float*)(lds + wave * 16384);
    constexpr int I_IN = (DM / 64) * (DIN / 32), I_OUT = (DM / 64) * (DM / 32), I_UP = (DM / 64) * (DFF / 32), I_DN = (DFF / 64) * (DM / 32);
    constexpr int PER_L = I_IN + I_OUT + I_UP + I_DN;
    for (int it = gw; it < DEPTH * PER_L; it += NGW) {
        const int l = it / PER_L; int r = it % PER_L;
        if (r < I_IN) { transpose_item<true>(a.w_in + (size_t)l * DM * DIN, a.g_mix_pre + l * DM, DM, DIN, (bf16*)(ws + WS_WIN) + (size_t)l * DINP * DM, scr, r, lane); continue; } r -= I_IN;
        if (r < I_OUT) { transpose_item<false>(a.w_out + (size_t)l * DM * DM, nullptr, DM, DM, (bf16*)(ws + WS_WOUT) + (size_t)l * DM * DM, scr, r, lane); continue; } r -= I_OUT;
        if (r < I_UP) { transpose_item<false>(a.w_up + (size_t)l * DM * DFF, a.g_mlp_pre + l * DM, DM, DFF, (bf16*)(ws + WS_WUP) + (size_t)l * DFF * DM, scr, r, lane); continue; } r -= I_UP;
        transpose_item<false>(a.w_down + (size_t)l * DFF * DM, nullptr, DFF, DM, (bf16*)(ws + WS_WDN) + (size_t)l * DM * DFF, scr, r, lane);
    }
    for (int i = gw * 64 + lane; i < DEPTH * 16384; i += NGW * 64) { const int l = i / 16384, r = i % 16384;
        ((u32x4*)((bf16*)(ws + WS_WIN) + ((size_t)l * DINP + DIN) * DM))[r] = (u32x4){0u, 0u, 0u, 0u}; }
    float* ct = (float*)(ws + WS_ROPE); float* st = ct + SEQ * 32;
    for (int i = gw * 64 + lane; i < SEQ * 32; i += NGW * 64) { const int s = i >> 5, k = i & 31;
        const float lin = (k == 31) ? 1.0f : (float)k * (1.0f / 31.0f); const float invf = 1.0f / exp2f(lin * 13.287712379549449f); const float ang = (float)s * invf; double t = (double)ang * 0.15915494309189535; t -= rint(t); const float tf = (float)t;
        ct[i] = __builtin_amdgcn_cosf(tf); st[i] = __builtin_amdgcn_sinf(tf); }
    for (int m = gw; m < M; m += NGW) row_to_bf16_rs(a.x + (size_t)m * DM, (bf16*)(ws + WS_H) + (size_t)m * DM, (float*)(ws + WS_RS) + m, lane);
}

__device__ __forceinline__ void ephase(const float* xf, bf16* xb, const bf16* y, const float* ga, float* fout, float* rs, int gw, int NGW, int lane) {
    for (int m = gw; m < M; m += NGW) {
        const u32x2* yr = (const u32x2*)(y + (size_t)m * DM) + lane; u32x2* xbr = (u32x2*)(xb + (size_t)m * DM) + lane;
        f32x4 xv[4], yv[4]; float sq = 0.f;
#pragma unroll
        for (int j = 0; j < 4; ++j) { const u32x2 w = yr[64 * j]; yv[j] = (f32x4){bflo(w.x), bfhi(w.x), bflo(w.y), bfhi(w.y)};
            if (xf) xv[j] = ((const f32x4*)(xf + (size_t)m * DM) + lane)[64 * j]; else { const u32x2 xw = xbr[64 * j]; xv[j] = (f32x4){bflo(xw.x), bfhi(xw.x), bflo(xw.y), bfhi(xw.y)}; }
            sq += (yv[j].x * yv[j].x + yv[j].y * yv[j].y) + (yv[j].z * yv[j].z + yv[j].w * yv[j].w); }
        const float r1 = rsqrtf(wave_sum(sq) * (1.f / DM) + EPS); float s2 = 0.f;
#pragma unroll
        for (int j = 0; j < 4; ++j) { const f32x4 gg = ((const f32x4*)ga)[lane + 64 * j]; xv[j] = xv[j] + yv[j] * r1 * gg;
            s2 += (xv[j].x * xv[j].x + xv[j].y * xv[j].y) + (xv[j].z * xv[j].z + xv[j].w * xv[j].w); }
        if (fout) { f32x4* xo = (f32x4*)(fout + (size_t)m * DM) + lane;
#pragma unroll
            for (int j = 0; j < 4; ++j) xo[64 * j] = xv[j];
        } else {
#pragma unroll
            for (int j = 0; j < 4; ++j) { u32x2 w; w.x = pk2(xv[j].x, xv[j].y); w.y = pk2(xv[j].z, xv[j].w); xbr[64 * j] = w; }
            const float r2 = rsqrtf(wave_sum(s2) * (1.f / DM) + EPS); if (lane == 0) rs[m] = r2; }
    }
}

constexpr int VTS = 72;
__device__ __forceinline__ void scatter8(LAS bf16* T, int row0, int col, u32x4 v) {
    T[(row0 + 0) * VTS + col] = (bf16)(v.x & 0xffffu); T[(row0 + 1) * VTS + col] = (bf16)(v.x >> 16);
    T[(row0 + 2) * VTS + col] = (bf16)(v.y & 0xffffu); T[(row0 + 3) * VTS + col] = (bf16)(v.y >> 16);
    T[(row0 + 4) * VTS + col] = (bf16)(v.z & 0xffffu); T[(row0 + 5) * VTS + col] = (bf16)(v.z >> 16);
    T[(row0 + 6) * VTS + col] = (bf16)(v.w & 0xffffu); T[(row0 + 7) * VTS + col] = (bf16)(v.w >> 16);
}
__device__ __forceinline__ bf16x8 ld_tr_pair(const LAS bf16* T, int row, int col_lo, int col_hi) {
    const u32x2 lo = *(const LAS u32x2*)(T + row * VTS + col_lo), hi = *(const LAS u32x2*)(T + row * VTS + col_hi);
    const u32x4 w = (u32x4){lo.x, lo.y, hi.x, hi.y}; return __builtin_bit_cast(bf16x8, w);
}
__device__ __forceinline__ bf16x8 pack_p(const f32x4 a, const f32x4 b) {
    const u32x4 w = (u32x4){pk2(a[0], a[1]), pk2(a[2], a[3]), pk2(b[0], b[1]), pk2(b[2], b[3])}; return __builtin_bit_cast(bf16x8, w);
}
constexpr int KLS = 136;
__device__ __forceinline__ void attn_unit(LAS unsigned char* lds, const bf16* u, const float* relb, bf16* ymix, int b, int n, int hp, int tid, int wid, int lane) {
    const int fr = lane & 15, fq = lane >> 4;
    LAS bf16* Vt0 = (LAS bf16*)lds;
    LAS bf16* Kl0 = (LAS bf16*)(lds + 2 * 128 * VTS * 2);
    LAS float* bl = (LAS float*)(lds + 2 * 128 * VTS * 2 + 2 * 64 * KLS * 2);
    const int hl = wid >> 2, qg = wid & 3, head = 2 * hp + hl;
    const size_t tok_q = (size_t)b * SEQ + n * 64 + qg * 16 + fr;
    const int c0 = n >= 8 ? 0 : 8 - n;
    const int kkey = tid >> 3, kd0 = (tid & 7) * 16;
    const size_t ktok0 = (size_t)b * SEQ + (size_t)(n + c0 - 8) * 64;
    const bf16* vsrc = u + (ktok0 + lane) * DINP + U_AV + (2 * hp) * 64 + 16 * wid;
    const bf16* ksrc = u + (ktok0 + kkey) * DINP + U_AK + (2 * hp) * 64 + kd0;
    u32x4 v0 = *(const u32x4*)vsrc, v1 = *(const u32x4*)(vsrc + 8);
    u32x4 k0 = *(const u32x4*)ksrc, k1 = *(const u32x4*)(ksrc + 8);
    u32x4 v0n = v0, v1n = v1, k0n = k0, k1n = k1;
    if (c0 < 8) { vsrc += (size_t)64 * DINP; ksrc += (size_t)64 * DINP;
        v0n = *(const u32x4*)vsrc; v1n = *(const u32x4*)(vsrc + 8); k0n = *(const u32x4*)ksrc; k1n = *(const u32x4*)(ksrc + 8); }
    bf16x8 Qb[2];
#pragma unroll
    for (int ks = 0; ks < 2; ++ks) Qb[ks] = *(const bf16x8*)(u + tok_q * DINP + U_AQ + head * 64 + ks * 32 + 8 * fq);
    LDS_BARRIER();
    for (int i = tid; i < 2 * 257; i += NT) { const int h2 = i / 257, k = i % 257; bl[h2 * 260 + k] = relb[(2 * hp + h2) * 257 + k] * LOG2E; }
    float m_run = -1e30f, l_run = 0.f; f32x4 O[4];
#pragma unroll
    for (int dt = 0; dt < 4; ++dt) O[dt] = (f32x4){0.f, 0.f, 0.f, 0.f};
    for (int c = c0; c <= 8; ++c) {
        LAS bf16* Vt = Vt0 + (c & 1) * 128 * VTS; LAS bf16* Kl = Kl0 + (c & 1) * 64 * KLS;
        *(LAS u32x4*)(Kl + kkey * KLS + kd0) = k0; *(LAS u32x4*)(Kl + kkey * KLS + kd0 + 8) = k1;
        scatter8(Vt, 16 * wid, lane, v0); scatter8(Vt, 16 * wid + 8, lane, v1);
        v0 = v0n; v1 = v1n; k0 = k0n; k1 = k1n;
        if (c < 7) { vsrc += (size_t)64 * DINP; ksrc += (size_t)64 * DINP;
            v0n = *(const u32x4*)vsrc; v1n = *(const u32x4*)(vsrc + 8); k0n = *(const u32x4*)ksrc; k1n = *(const u32x4*)(ksrc + 8); }
        LDS_BARRIER();
        f32x4 st[4];
#pragma unroll
        for (int kt = 0; kt < 4; ++kt) { st[kt] = (f32x4){0.f, 0.f, 0.f, 0.f};
#pragma unroll
            for (int ks = 0; ks < 2; ++ks) { const bf16x8 Ka = *(const LAS bf16x8*)(Kl + (kt * 16 + fr) * KLS + hl * 64 + ks * 32 + 8 * fq); st[kt] = MFMA16(Ka, Qb[ks], st[kt]); } }
        float mx = -1e30f;
        if (c >= 6) { const int relbase = (qg * 16 + fr) + 64 * (8 - c);
#pragma unroll
            for (int kt = 0; kt < 4; ++kt)
#pragma unroll
                for (int r = 0; r < 4; ++r) { const int rel = relbase - (kt * 16 + 4 * fq + r); const int idx = (rel < 128 ? rel : 128) + 128;
                    const float sv = st[kt][r] * (0.125f * LOG2E) + bl[hl * 260 + idx]; st[kt][r] = sv; mx = fmaxf(mx, sv); }
        } else { const float bc = bl[hl * 260 + 256];
#pragma unroll
            for (int kt = 0; kt < 4; ++kt)
#pragma unroll
                for (int r = 0; r < 4; ++r) { const float sv = st[kt][r] * (0.125f * LOG2E) + bc; st[kt][r] = sv; mx = fmaxf(mx, sv); } }
        if (__builtin_amdgcn_ballot_w64(mx > m_run + 8.f) != 0ull) {
            mx = fmaxf(mx, __shfl_xor(mx, 16)); mx = fmaxf(mx, __shfl_xor(mx, 32));
            const float m_new = fmaxf(m_run, mx), alpha = fexp2(m_run - m_new);
            l_run *= alpha; m_run = m_new;
#pragma unroll
            for (int dt = 0; dt < 4; ++dt) O[dt] = O[dt] * alpha;
        }
        float psum = 0.f;
#pragma unroll
        for (int kt = 0; kt < 4; ++kt)
#pragma unroll
            for (int r = 0; r < 4; ++r) { const float p = fexp2(st[kt][r] - m_run); st[kt][r] = p; psum += p; }
        l_run += psum;
#pragma unroll
        for (int kk = 0; kk < 2; ++kk) { const bf16x8 pb = pack_p(st[2 * kk], st[2 * kk + 1]);
#pragma unroll
            for (int dt = 0; dt < 4; ++dt) { const bf16x8 Va = ld_tr_pair(Vt, hl * 64 + dt * 16 + fr, 32 * kk + 4 * fq, 32 * kk + 16 + 4 * fq); O[dt] = MFMA16(Va, pb, O[dt]); } }
    }
    l_run += __shfl_xor(l_run, 16); l_run += __shfl_xor(l_run, 32);
    const float inv = 1.f / l_run;
#pragma unroll
    for (int dt = 0; dt < 4; ++dt) { u32x2 w; w.x = pk2(O[dt][0] * inv, O[dt][1] * inv); w.y = pk2(O[dt][2] * inv, O[dt][3] * inv);
        *(u32x2*)(ymix + tok_q * DM + Y_ATT + head * 64 + dt * 16 + 4 * fq) = w; }
}

__device__ __forceinline__ void conv_unit(LAS unsigned char* lds, const bf16* u, const float* cw, const float* cb, const float* lng, const float* lnb, bf16* ymix, int b, int n, int tid, int wid, int lane) {
    LAS float* yb = (LAS float*)lds;
    __syncthreads();
    for (int i = tid; i < 94 * 32; i += NT) { const int tt = i >> 5, cgp = i & 31; const int t = n * 64 - 30 + tt;
        f32x4 o0 = (f32x4){0.f, 0.f, 0.f, 0.f}, o1 = o0;
        if (t >= 0) { const bf16* src = u + ((size_t)b * SEQ + t) * DINP + U_CA + cgp * 8; const u32x4 av = *(const u32x4*)src, gv = *(const u32x4*)(src + CW);
            o0 = (f32x4){bflo(av.x) * sigmoidf_(bflo(gv.x)), bfhi(av.x) * sigmoidf_(bfhi(gv.x)), bflo(av.y) * sigmoidf_(bflo(gv.y)), bfhi(av.y) * sigmoidf_(bfhi(gv.y))};
            o1 = (f32x4){bflo(av.z) * sigmoidf_(bflo(gv.z)), bfhi(av.z) * sigmoidf_(bfhi(gv.z)), bflo(av.w) * sigmoidf_(bflo(gv.w)), bfhi(av.w) * sigmoidf_(bfhi(gv.w))}; }
        *(LAS f32x4*)(yb + tt * 256 + cgp * 8) = o0; *(LAS f32x4*)(yb + tt * 256 + cgp * 8 + 4) = o1; }
    __syncthreads();
    const int ch = tid & 255, half = tid >> 8;
    float w[CK];
#pragma unroll
    for (int j = 0; j < CK; ++j) w[j] = cw[j * CW + ch];
    float acc[32]; const float bias = cb[ch];
    { float yv[62];
#pragma unroll
      for (int r = 0; r < 62; ++r) yv[r] = yb[(half * 32 + r) * 256 + ch];
#pragma unroll
      for (int i = 0; i < 32; ++i) { float sacc = bias;
#pragma unroll
          for (int j = 0; j < CK; ++j) sacc += w[j] * yv[i + j];
          acc[i] = sacc; } }
    __syncthreads();
#pragma unroll
    for (int i = 0; i < 32; ++i) yb[(half * 32 + i) * 256 + ch] = acc[i];
    __syncthreads();
    const f32x4 gg = ((const f32x4*)lng)[lane], bb = ((const f32x4*)lnb)[lane];
    f32x4 v[8]; float sm[8], sq[8];
#pragma unroll
    for (int k = 0; k < 8; ++k) { v[k] = *(const LAS f32x4*)(yb + (wid * 8 + k) * 256 + 4 * lane); sm[k] = (v[k].x + v[k].y) + (v[k].z + v[k].w); }
#pragma unroll
    for (int o = 1; o < 64; o <<= 1)
#pragma unroll
        for (int k = 0; k < 8; ++k) sm[k] += __shfl_xor(sm[k], o);
#pragma unroll
    for (int k = 0; k < 8; ++k) { v[k] = v[k] - sm[k] * (1.f / 256.f); sq[k] = (v[k].x * v[k].x + v[k].y * v[k].y) + (v[k].z * v[k].z + v[k].w * v[k].w); }
#pragma unroll
    for (int o = 1; o < 64; o <<= 1)
#pragma unroll
        for (int k = 0; k < 8; ++k) sq[k] += __shfl_xor(sq[k], o);
#pragma unroll
    for (int k = 0; k < 8; ++k) { const int t = wid * 8 + k; const float rstd = rsqrtf(sq[k] * (1.f / 256.f) + EPS);
        f32x4 y = v[k] * rstd * gg + bb; y = (f32x4){y.x * sigmoidf_(y.x), y.y * sigmoidf_(y.y), y.z * sigmoidf_(y.z), y.w * sigmoidf_(y.w)};
        u32x2 o; o.x = pk2(y.x, y.y); o.y = pk2(y.z, y.w);
        *(u32x2*)(ymix + ((size_t)b * SEQ + n * 64 + t) * DM + Y_CONV + 4 * lane) = o; }
}

__device__ __forceinline__ float ret_logg2(int h) { return log2f(1.f - exp2f(-5.f - (float)h)); }
__device__ __forceinline__ void rope8(const u32x4 a, const u32x4 c, const float* ct, const float* st, int pos, int dg, float scale, float (&o1)[8], float (&o2)[8]) {
    const f32x4 c0 = *(const f32x4*)(ct + pos * 32 + dg * 8), c1 = *(const f32x4*)(ct + pos * 32 + dg * 8 + 4);
    const f32x4 s0 = *(const f32x4*)(st + pos * 32 + dg * 8), s1 = *(const f32x4*)(st + pos * 32 + dg * 8 + 4);
    const float x1[8] = {bflo(a.x), bfhi(a.x), bflo(a.y), bfhi(a.y), bflo(a.z), bfhi(a.z), bflo(a.w), bfhi(a.w)};
    const float x2[8] = {bflo(c.x), bfhi(c.x), bflo(c.y), bfhi(c.y), bflo(c.z), bfhi(c.z), bflo(c.w), bfhi(c.w)};
    const float cs[8] = {c0.x, c0.y, c0.z, c0.w, c1.x, c1.y, c1.z, c1.w}, sn[8] = {s0.x, s0.y, s0.z, s0.w, s1.x, s1.y, s1.z, s1.w};
#pragma unroll
    for (int e = 0; e < 8; ++e) { o1[e] = (x1[e] * cs[e] - x2[e] * sn[e]) * scale; o2[e] = (x2[e] * cs[e] + x1[e] * sn[e]) * scale; }
}
__device__ __forceinline__ bf16x8 pack8(const float (&o)[8]) { const u32x4 w = (u32x4){pk2(o[0], o[1]), pk2(o[2], o[3]), pk2(o[4], o[5]), pk2(o[6], o[7])}; return __builtin_bit_cast(bf16x8, w); }
__device__ __forceinline__ void stage_vt(LAS bf16* Vt, const bf16* u, size_t tok0, int tid) {
    for (int i = tid; i < 64 * 48; i += NT) { const int j = i & 63, cg8 = i >> 6; const u32x4 v = *(const u32x4*)(u + (tok0 + j) * DINP + U_RV + cg8 * 8); scatter8(Vt, cg8 * 8, j, v); }
}
__device__ __forceinline__ void retkv_unit(LAS unsigned char* lds, const bf16* u, float* kv, int b, int n, int tid, int wid, int lane) {
    const int fr = lane & 15, fq = lane >> 4;
    LAS bf16* Vt = (LAS bf16*)lds; LAS bf16* Kt = Vt + 384 * VTS;
    const size_t tok0 = (size_t)b * SEQ + n * 64;
    LDS_BARRIER();
    stage_vt(Vt, u, tok0, tid);
    for (int i = tid; i < 64 * 48; i += NT) { const int j = i & 63, cg8 = i >> 6, h = cg8 >> 3; const u32x4 a = *(const u32x4*)(u + (tok0 + j) * DINP + U_RK + cg8 * 8);
        const float z = fexp2((float)(63 - j) * ret_logg2(h));
        const u32x4 w = (u32x4){pk2(bflo(a.x) * z, bfhi(a.x) * z), pk2(bflo(a.y) * z, bfhi(a.y) * z), pk2(bflo(a.z) * z, bfhi(a.z) * z), pk2(bflo(a.w) * z, bfhi(a.w) * z)};
        scatter8(Kt, cg8 * 8, j, w); }
    LDS_BARRIER();
    for (int t = wid; t < 24; t += NWAVES) { const int h = t >> 2, et = t & 3;
        bf16x8 Va[2];
#pragma unroll
        for (int ks = 0; ks < 2; ++ks) Va[ks] = *(const LAS bf16x8*)(Vt + (h * 64 + et * 16 + fr) * VTS + ks * 32 + 8 * fq);
        float* dst = kv + (((size_t)b * NC + n) * RH + h) * 4096;
#pragma unroll
        for (int dt = 0; dt < 4; ++dt) { f32x4 acc = (f32x4){0.f, 0.f, 0.f, 0.f};
#pragma unroll
            for (int ks = 0; ks < 2; ++ks) { const bf16x8 Kb = *(const LAS bf16x8*)(Kt + (h * 64 + dt * 16 + fr) * VTS + ks * 32 + 8 * fq); acc = MFMA16(Va[ks], Kb, acc); }
#pragma unroll
            for (int r = 0; r < 4; ++r) dst[(et * 16 + 4 * fq + r) * 64 + dt * 16 + fr] = acc[r]; }
    }
}
__device__ __forceinline__ void scan_phase(const float* kv, bf16* state, int bx, int G, int tid) {
    constexpr int TOT = BATCH * RH * 4096;
    const int per_b = (TOT + G - 1) / G;
    for (int e = tid; e < per_b; e += NT) { const int g = bx * per_b + e; if (g >= TOT) break;
        const int ed = g & 4095, bh = g >> 12, h = bh % RH, b = bh / RH;
        const float gc = fexp2(64.f * ret_logg2(h)); float S = 0.f;
#pragma unroll 8
        for (int n = 0; n < NC; ++n) { const size_t idx = (((size_t)b * NC + n) * RH + h) * 4096 + ed; const float v = kv[idx]; state[idx] = (bf16)(pk2(S, 0.f) & 0xffffu); S = S * gc + v; }
    }
}
__device__ __forceinline__ void retout_unit(LAS unsigned char* lds, const bf16* u, const bf16* state, bf16* ymix, int b, int n, int tid, int wid, int lane) {
    const int fr = lane & 15, fq = lane >> 4;
    LAS bf16* Vt = (LAS bf16*)lds;
    const size_t tok0 = (size_t)b * SEQ + n * 64;
    LDS_BARRIER();
    stage_vt(Vt, u, tok0, tid);
    LDS_BARRIER();
    for (int t = wid; t < 24; t += NWAVES) { const int h = t >> 2, ig = t & 3; const float lg2 = ret_logg2(h);
        const size_t tok_i = tok0 + ig * 16 + fr;
        bf16x8 Qb[2];
#pragma unroll
        for (int ks = 0; ks < 2; ++ks) Qb[ks] = *(const bf16x8*)(u + tok_i * DINP + U_RQ + h * 64 + ks * 32 + 8 * fq);
        u32x2 gw2[4];
#pragma unroll
        for (int et = 0; et < 4; ++et) gw2[et] = *(const u32x2*)(u + tok_i * DINP + U_RG + h * 64 + et * 16 + 4 * fq);
        f32x4 y[4];
        const bf16* sp = state + (((size_t)b * NC + n) * RH + h) * 4096;
        const float xi = fexp2((float)(ig * 16 + fr + 1) * lg2);
#pragma unroll
        for (int et = 0; et < 4; ++et) { y[et] = (f32x4){0.f, 0.f, 0.f, 0.f};
#pragma unroll
            for (int ks = 0; ks < 2; ++ks) { const bf16x8 Sa = *(const bf16x8*)(sp + (et * 16 + fr) * 64 + ks * 32 + 8 * fq); y[et] = MFMA16(Sa, Qb[ks], y[et]); }
            y[et] = y[et] * xi; }
        f32x4 sc[4];
#pragma unroll
        for (int jt = 0; jt < 4; ++jt) { sc[jt] = (f32x4){0.f, 0.f, 0.f, 0.f};
            if (jt <= ig) {
#pragma unroll
                for (int ks = 0; ks < 2; ++ks) { const bf16x8 Ka = *(const bf16x8*)(u + (tok0 + jt * 16 + fr) * DINP + U_RK + h * 64 + ks * 32 + 8 * fq); sc[jt] = MFMA16(Ka, Qb[ks], sc[jt]); }
#pragma unroll
                for (int r = 0; r < 4; ++r) { const int dlt = (ig * 16 + fr) - (jt * 16 + 4 * fq + r); sc[jt][r] = dlt >= 0 ? sc[jt][r] * fexp2((float)dlt * lg2) : 0.f; }
            } }
#pragma unroll
        for (int kk = 0; kk < 2; ++kk) { const bf16x8 pb = pack_p(sc[2 * kk], sc[2 * kk + 1]);
#pragma unroll
            for (int et = 0; et < 4; ++et) { const bf16x8 Va = ld_tr_pair(Vt, h * 64 + et * 16 + fr, 32 * kk + 4 * fq, 32 * kk + 16 + 4 * fq); y[et] = MFMA16(Va, pb, y[et]); } }
        float sm = 0.f;
#pragma unroll
        for (int et = 0; et < 4; ++et) sm += (y[et][0] + y[et][1]) + (y[et][2] + y[et][3]);
        sm += __shfl_xor(sm, 16); sm += __shfl_xor(sm, 32);
        const float mean = sm * (1.f / 64.f); float q = 0.f;
#pragma unroll
        for (int et = 0; et < 4; ++et) { y[et] = y[et] - mean; q += (y[et][0] * y[et][0] + y[et][1] * y[et][1]) + (y[et][2] * y[et][2] + y[et][3] * y[et][3]); }
        q += __shfl_xor(q, 16); q += __shfl_xor(q, 32);
        const float rstd = rsqrtf(q * (1.f / 64.f) + EPS);
#pragma unroll
        for (int et = 0; et < 4; ++et) {
            const float g0 = bflo(gw2[et].x), g1 = bfhi(gw2[et].x), g2 = bflo(gw2[et].y), g3 = bfhi(gw2[et].y);
            u32x2 o; o.x = pk2(g0 * sigmoidf_(g0) * y[et][0] * rstd, g1 * sigmoidf_(g1) * y[et][1] * rstd); o.y = pk2(g2 * sigmoidf_(g2) * y[et][2] * rstd, g3 * sigmoidf_(g3) * y[et][3] * rstd);
            *(u32x2*)(ymix + tok_i * DM + Y_RET + h * 64 + et * 16 + 4 * fq) = o; }
    }
}

#define XB_TMO      128
#define XB_XCNT(j)  (256  + 64 * (j))
#define XB_XSUB(j)  (1280 + 64 * (j))
#define XB_XGEN(j)  (2304 + 64 * (j))
#define XB_TOP      3328
#define XB_TOPGEN   3392
#define XCD_BAR_WORDS 3456
#define XB_SPIN_CAP (1u << 18)

__device__ __forceinline__ unsigned xb_ld(unsigned* p)              { return __hip_atomic_load(p, __ATOMIC_RELAXED, __HIP_MEMORY_SCOPE_AGENT); }
__device__ __forceinline__ unsigned xb_add(unsigned* p, unsigned v) { return __hip_atomic_fetch_add(p, v, __ATOMIC_RELAXED, __HIP_MEMORY_SCOPE_AGENT); }
__device__ __forceinline__ unsigned xb_xcc_id() { return (unsigned)__builtin_amdgcn_s_getreg((3 << 11) | 20) & 0xFu; }
#define XB_SPIN(cond, bar) do { unsigned _sp = 0; while (cond) { __builtin_amdgcn_s_sleep(1); \
    if ((++_sp & 255u) == 0u) { if (xb_ld(&(bar)[XB_TMO])) break; if (_sp > XB_SPIN_CAP) { atomicAdd(&(bar)[XB_TMO], 1u); break; } } } } while (0)

struct XcdBarrier {
    unsigned* bar; unsigned x;
    volatile LAS unsigned* st;
};

__device__ __forceinline__ XcdBarrier xcd_barrier_post(unsigned* bar, volatile LAS unsigned* st) {
    XcdBarrier b; b.bar = bar; b.x = xb_xcc_id(); b.st = st;
    if (threadIdx.x == 0) (void)xb_add(&bar[XB_XCNT(b.x)], 1u);
    return b;
}
__device__ __forceinline__ void xcd_barrier_complete(unsigned* bar, unsigned x, unsigned& nloc, unsigned& nx) {
    const unsigned G = gridDim.x * gridDim.y * gridDim.z;
    unsigned sum, cnt, mine, sp = 0u;
    for (;;) {
        sum = 0u; cnt = 0u; mine = 0u;
#pragma unroll
        for (unsigned j = 0; j < 16; ++j) { const unsigned c = xb_ld(&bar[XB_XCNT(j)]); sum += c; cnt += (c > 0u) ? 1u : 0u; mine = (j == x) ? c : mine; }
        if (sum == G) break;
        __builtin_amdgcn_s_sleep(1);
        if ((++sp & 255u) == 0u) { if (xb_ld(&bar[XB_TMO])) break; if (sp > XB_SPIN_CAP) { atomicAdd(&bar[XB_TMO], 1u); break; } }
    }
    nloc = mine > 0u ? mine : 1u; nx = cnt > 0u ? cnt : 1u;
}

__device__ __forceinline__ void xcd_barrier(const XcdBarrier& b) {
    asm volatile("s_waitcnt vmcnt(0)" ::: "memory");
    __syncthreads();
    if (threadIdx.x == 0) {
        unsigned* bar = b.bar;
        __builtin_amdgcn_s_waitcnt(0);
        unsigned nloc = b.st[0], nx = b.st[1];
        if (nloc == 0u) { xcd_barrier_complete(bar, b.x, nloc, nx); b.st[0] = nloc; b.st[1] = nx; }
        const unsigned old = xb_add(&bar[XB_XSUB(b.x)], 1u);
        const unsigned gen = old / nloc;
        if (old + 1u == (gen + 1u) * nloc) {
            __builtin_amdgcn_fence(__ATOMIC_RELEASE, "agent");
            asm volatile("s_waitcnt vmcnt(0)" ::: "memory");
            const unsigned og = xb_add(&bar[XB_TOP], 1u);
            const unsigned tg = og / nx;
            if (og + 1u == (tg + 1u) * nx) xb_add(&bar[XB_TOPGEN], 1u);
            else XB_SPIN(xb_ld(&bar[XB_TOPGEN]) == tg, bar);
            __builtin_amdgcn_fence(__ATOMIC_ACQUIRE, "agent");
            xb_add(&bar[XB_XGEN(b.x)], 1u);
            asm volatile("s_waitcnt vmcnt(0)" ::: "memory");
        } else {
            XB_SPIN(xb_ld(&bar[XB_XGEN(b.x)]) == gen, bar);
            __builtin_amdgcn_fence(__ATOMIC_ACQUIRE, "agent");
            asm volatile("s_waitcnt vmcnt(0)" ::: "memory");
        }
    }
    __syncthreads();
}

#ifndef PROBE
#define PROBE 0
#endif
#define REP(bit) for (int rep_ = 0; rep_ < ((PROBE & (bit)) ? 2 : 1); ++rep_)
constexpr int N_PHASES = 1 + 9 * DEPTH;
#define IN(k) (lo <= (k) && (k) < hi)
#ifdef NO_SYNC
#define SEAM(k) do { } while (0)
#else
#define SEAM(k) do { if (lo <= (k) && (k) + 1 < hi) { REP(32) { xcd_barrier(bar); } } } while (0)
#endif
template <int l> __device__ __forceinline__ void layer_phases(const Args& a, LAS unsigned char* lds, const XcdBarrier& bar, int lo, int hi, int tid, int lane, int wid, int G, int bx, int gw, int NGW) {
    unsigned char* ws = a.ws;
    bf16* Hb = (bf16*)(ws + WS_H); bf16* MIXb = (bf16*)(ws + WS_MIX); bf16* Ub = (bf16*)(ws + WS_U); bf16* YM = (bf16*)(ws + WS_YMIX); bf16* F1 = (bf16*)(ws + WS_F1);
    float* KV = (float*)(ws + WS_KV); bf16* STt = (bf16*)(ws + WS_ST); float* RS = (float*)(ws + WS_RS);
    const float* ct = (const float*)(ws + WS_ROPE); const float* st = ct + SEQ * 32;
        const int pb = 1 + 9 * l;
        if (IN(pb + 0)) {
#ifndef NO_GEMM
            const pg8::Gemm g{Hb, (const bf16*)(ws + WS_WIN) + (size_t)l * DINP * DM, M, DINP, DM}; const pg8::EpiOut E{Ub, DINP, 2, ct, st, U_RQ, U_RV, U_RK, SEQ, RS};
            pg8::StaticOrder S; S.init(M, DINP, G, bx);
            REP(128) pg8::gemm_phase<pg8::EpiOut, pg8::StaticOrder, true, true>(lds, g, S, E);
#endif
        }
        SEAM(pb + 0);
        if (IN(pb + 1)) {
#ifndef NO_RETKV
            for (int it = bx; it < 512; it += G) { REP(4) retkv_unit(lds, Ub, KV, it / NC, it % NC, tid, wid, lane); }
#endif
        }
        SEAM(pb + 1);
        if (IN(pb + 2)) {
            REP(8) scan_phase(KV, STt, bx, G, tid);
            const float* relb = a.rel_bias + (size_t)l * AH * 257;
            if ((G & 7) == 0) {
#ifndef NO_ATTN
                const int per_x = G >> 3, xx = bx & 7, cc = bx >> 3;
                for (int idx = cc; idx < 192; idx += per_x) { const int id = xx * 192 + idx; const int bh = id >> 7, n = id & 127;
                    REP(1) attn_unit(lds, Ub, relb, YM, bh / 3, n, bh % 3, tid, wid, lane); }
#endif
            } else {
                for (int it = bx; it < 1536; it += G) { const int hp = it % 3, bn = it / 3; attn_unit(lds, Ub, relb, YM, bn / NC, bn % NC, hp, tid, wid, lane); }
            }
#ifndef NO_CONV
            for (int it = bx; it < 512; it += G) { REP(2) conv_unit(lds, Ub, a.conv_w + (size_t)l * CK * CW, a.conv_b + l * CW, a.conv_ln_g + l * CW, a.conv_ln_b + l * CW, YM, it / NC, it % NC, tid, wid, lane); }
#endif
        }
        SEAM(pb + 2);
        if (IN(pb + 3)) {
#ifndef NO_RETOUT
            REP(16) for (int it = bx; it < 512; it += G) retout_unit(lds, Ub, STt, YM, it / NC, it % NC, tid, wid, lane);
#endif
        }
        SEAM(pb + 3);
        if (IN(pb + 4)) {
#ifndef NO_GEMM
            const pg8::Gemm g{YM, (const bf16*)(ws + WS_WOUT) + (size_t)l * DM * DM, M, DM, DM}; const pg8::EpiOut E{MIXb, DM, 0, nullptr, nullptr, 0, 0, 0, 1, nullptr};
            pg8::StaticOrder S; S.init(M, DM, G, bx);
            REP(128) pg8::gemm_phase<pg8::EpiOut, pg8::StaticOrder, true, true>(lds, g, S, E);
#endif
        }
        SEAM(pb + 4);
        if (IN(pb + 5)) ephase(l == 0 ? a.x : nullptr, Hb, MIXb, a.g_mix_post + l * DM, nullptr, RS, gw, NGW, lane);
        SEAM(pb + 5);
        if (IN(pb + 6)) {
#ifndef NO_GEMM
            const pg8::Gemm g{Hb, (const bf16*)(ws + WS_WUP) + (size_t)l * DFF * DM, M, DFF, DM}; const pg8::EpiOut E{F1, DFF, 1, nullptr, nullptr, 0, 0, 0, 1, RS};
            pg8::StaticOrder S; S.init(M, DFF, G, bx);
            REP(128) pg8::gemm_phase<pg8::EpiOut, pg8::StaticOrder, true, true>(lds, g, S, E);
#if (PROBE & 256)
            pg8::gemm_phase<pg8::EpiOut, pg8::StaticOrder, true, true>(lds, g, S, E);
#endif
#endif
        }
        SEAM(pb + 6);
        if (IN(pb + 7)) {
#ifndef NO_GEMM
            const pg8::Gemm g{F1, (const bf16*)(ws + WS_WDN) + (size_t)l * DM * DFF, M, DM, DFF}; const pg8::EpiOut E{MIXb, DM, 0, nullptr, nullptr, 0, 0, 0, 1, nullptr};
            pg8::StaticOrder S; S.init(M, DM, G, bx);
            REP(128) pg8::gemm_phase<pg8::EpiOut, pg8::StaticOrder, true, true>(lds, g, S, E);
#endif
        }
        SEAM(pb + 7);
        if (IN(pb + 8)) ephase(nullptr, Hb, MIXb, a.g_mlp_post + l * DM, (l + 1 < DEPTH) ? nullptr : a.out, RS, gw, NGW, lane);
        SEAM(pb + 8);
    }
__global__ void __launch_bounds__(NT, 2) fwd_kernel(Args a) {
    extern __shared__ __attribute__((aligned(16))) unsigned char lds_raw[];
    LAS unsigned char* lds = (LAS unsigned char*)lds_raw;
    const int tid = threadIdx.x, lane = tid & 63, wid = __builtin_amdgcn_readfirstlane(tid >> 6);
    const int G = gridDim.x, bx = blockIdx.x;
    const int gw = bx * NWAVES + wid, NGW = G * NWAVES;
    unsigned char* ws = a.ws;
    bf16* Hb = (bf16*)(ws + WS_H); bf16* MIXb = (bf16*)(ws + WS_MIX); bf16* Ub = (bf16*)(ws + WS_U); bf16* YM = (bf16*)(ws + WS_YMIX); bf16* F1 = (bf16*)(ws + WS_F1);
    float* KV = (float*)(ws + WS_KV); bf16* STt = (bf16*)(ws + WS_ST);
    const float* ct = (const float*)(ws + WS_ROPE); const float* st = ct + SEQ * 32;
    const int lo = a.ph_lo, hi = a.ph_hi;
    volatile LAS unsigned* stw = (volatile LAS unsigned*)(lds + 131072 + 64);
    unsigned* barw = (unsigned*)ws;
    if (tid < 2) stw[tid] = 0u;
    __syncthreads();
    const XcdBarrier bar = xcd_barrier_post(barw, stw);
    if (hi > N_PHASES) { __syncthreads(); cg::this_grid().sync(); }
    if (IN(0)) REP(64) prologue(a, lds, gw, NGW, wid, lane);
    SEAM(0);
    layer_phases<0>(a, lds, bar, lo, hi, tid, lane, wid, G, bx, gw, NGW);
    layer_phases<1>(a, lds, bar, lo, hi, tid, lane, wid, G, bx, gw, NGW);
}
#undef IN
#undef SEAM


#ifndef MULTI_LAUNCH
#define MULTI_LAUNCH 0
#endif
extern "C" void kernel_launch(void* const* d_in, const int* in_sizes, int n_in, void* d_out, int out_size, void* d_ws, size_t ws_size, hipStream_t stream) {
    static int grid = 0;
    if (grid == 0) {
        if (n_in != 14 || in_sizes[0] != M * DM || out_size != M * DM || ws_size < WS_END) { fprintf(stderr, "kernel_launch: unexpected shapes: n_in %d in0 %d out %d ws %zu\n", n_in, n_in > 0 ? in_sizes[0] : -1, out_size, ws_size); grid = -1; return; }
        int dev = 0, cus = 0, per_cu = 0;
        hipGetDevice(&dev); hipDeviceGetAttribute(&cus, hipDeviceAttributeMultiprocessorCount, dev);
        if (hipFuncSetAttribute((const void*)fwd_kernel, hipFuncAttributeMaxDynamicSharedMemorySize, LDS_BYTES) != hipSuccess) { fprintf(stderr, "kernel_launch: hipFuncSetAttribute failed\n"); grid = -1; return; }
        if (hipOccupancyMaxActiveBlocksPerMultiprocessor(&per_cu, (const void*)fwd_kernel, NT, LDS_BYTES) != hipSuccess || per_cu < 1) { fprintf(stderr, "kernel_launch: occupancy query says %d\n", per_cu); per_cu = 1; }
        (void)hipGetLastError();
        grid = cus * 1;
        fprintf(stderr, "kernel_launch: cus %d per_cu %d grid %d\n", cus, per_cu, grid);
    }
    if (grid < 0) return;
    Args a{};
    a.x = (const float*)d_in[0]; a.g_mix_pre = (const float*)d_in[1]; a.g_mix_post = (const float*)d_in[2]; a.g_mlp_pre = (const float*)d_in[3]; a.g_mlp_post = (const float*)d_in[4];
    a.w_in = (const float*)d_in[5]; a.rel_bias = (const float*)d_in[6]; a.conv_w = (const float*)d_in[7]; a.conv_b = (const float*)d_in[8]; a.conv_ln_g = (const float*)d_in[9]; a.conv_ln_b = (const float*)d_in[10];
    a.w_out = (const float*)d_in[11]; a.w_up = (const float*)d_in[12]; a.w_down = (const float*)d_in[13];
    a.out = (float*)d_out; a.ws = (unsigned char*)d_ws;
#if MULTI_LAUNCH
    for (int ph = 0; ph < N_PHASES; ++ph) { a.ph_lo = ph; a.ph_hi = ph + 1; hipLaunchKernelGGL(fwd_kernel, dim3(grid), dim3(NT), LDS_BYTES, stream, a); }
#else
    a.ph_lo = 0; a.ph_hi = N_PHASES;
    if (hipMemsetAsync(d_ws, 0, 16384, stream) != hipSuccess) { fprintf(stderr, "kernel_launch: memset of the barrier words failed\n"); return; }
    void* args[] = {&a};
    hipError_t e = hipLaunchCooperativeKernel((const void*)fwd_kernel, dim3(grid), dim3(NT), args, LDS_BYTES, stream);
    if (e != hipSuccess) fprintf(stderr, "cooperative launch failed: %s (grid %d)\n", hipGetErrorString(e), grid);
#endif
}
```
